# Optimizing an MI355X kernel written in HIP

```python
import functools
import jax, jax.numpy as jnp
from jax import lax
import numpy as np

D_MODEL = 1024
BATCH = 16
SEQ = 2048
DEPTH = 1
DEC_BATCH = 32
DEC_SEQ = 8
PAST_LEN = 16384
PAGE_SIZE = 128

HEAD_DIM = 64
N_HEADS_A = D_MODEL // 128
WIDTH_A = N_HEADS_A * HEAD_DIM
WIDTH_B = D_MODEL - WIDTH_A
MIX_WIDTH = WIDTH_A + WIDTH_B
DILATED_BRANCHES = ((128, 1), (512, 4), (2048, 16))
WIN_MAX = 2048
CONV_WIDTH = 31
D_FF = 2816
N_MEM = 256
N_HEADS_X = 4
HEAD_DIM_X = D_MODEL // N_HEADS_X
EPS = 1e-6

kernel_name = 'hybrid_dilated_conformer_decoder_step'


def rmsnorm(x, g):
    xf = x.astype(jnp.float32)
    y = xf * lax.rsqrt(jnp.mean(xf * xf, axis=-1, keepdims=True) + EPS)
    return (y * g.astype(jnp.float32)).astype(x.dtype)


def layernorm(x, g, b):
    xf = x.astype(jnp.float32)
    mu = jnp.mean(xf, axis=-1, keepdims=True)
    xc = xf - mu
    y = xc * lax.rsqrt(jnp.mean(xc * xc, axis=-1, keepdims=True) + EPS)
    return (y * g.astype(jnp.float32) + b.astype(jnp.float32)).astype(x.dtype)


def ffn_half_step(x, g, wg, wu, wd):
    h = rmsnorm(x, g)
    return x + 0.5 * ((jax.nn.silu(h @ wg) * (h @ wu)) @ wd)


def alibi_slopes(n):
    return 2.0 ** (-8.0 * jnp.arange(1, n + 1, dtype=jnp.float32) / n)


def project_in(h, w_in):
    B, T, _ = h.shape
    z = h @ w_in
    q, k, v, a, g = jnp.split(z, [WIDTH_A, 2 * WIDTH_A, 3 * WIDTH_A, 3 * WIDTH_A + WIDTH_B], axis=-1)
    heads = lambda t: t.reshape(B, T, N_HEADS_A, HEAD_DIM)
    return heads(q), heads(k), heads(v), a * jax.nn.sigmoid(g)


def conv_branch(u_ext, conv_w, conv_b, ln_g, ln_b):
    y = lax.conv_general_dilated(u_ext, conv_w[:, None, :], window_strides=(1,), padding='VALID',
                                 dimension_numbers=('NWC', 'WIO', 'NWC'),
                                 feature_group_count=u_ext.shape[-1])
    return jax.nn.silu(layernorm(y + conv_b, ln_g, ln_b))


def dilated_branch_prompt(q, k, v, slopes, window, dilation):
    B, S, H, Dh = q.shape
    w = window // dilation
    L = S // dilation
    nblk = -(-L // w)
    Lp = nblk * w
    split = lambda a: a.reshape(B, L, dilation, H, Dh)
    qb = jnp.pad(split(q), ((0, 0), (0, Lp - L), (0, 0), (0, 0), (0, 0))).reshape(B, nblk, w, dilation, H, Dh)
    kpad = ((0, 0), (w, Lp - L), (0, 0), (0, 0), (0, 0))
    ks = jnp.pad(split(k), kpad).reshape(B, nblk + 1, w, dilation, H, Dh)
    vs = jnp.pad(split(v), kpad).reshape(B, nblk + 1, w, dilation, H, Dh)
    kb = jnp.concatenate([ks[:, :-1], ks[:, 1:]], axis=2)
    vb = jnp.concatenate([vs[:, :-1], vs[:, 1:]], axis=2)
    s = jnp.einsum('bnqrhe,bnkrhe->bnrhqk', qb, kb).astype(jnp.float32) * (Dh ** -0.5)
    qi = jnp.arange(w)[:, None]
    kj = jnp.arange(2 * w)[None, :]
    dist = qi + w - kj
    blk = jnp.arange(nblk)[:, None, None]
    valid = (dist >= 0) & (dist <= w) & (blk * w + kj - w >= 0)
    bias = -slopes[:, None, None] * (dist * dilation).astype(jnp.float32)
    s = jnp.where(valid[None, :, None, None], s + bias, -jnp.inf)
    m = jnp.max(s, axis=-1)
    p = jnp.exp(s - m[..., None])
    den = jnp.sum(p, axis=-1)
    num = jnp.einsum('bnrhqk,bnkrhe->bnqrhe', p, vb.astype(jnp.float32))
    to_seq = lambda t: t.transpose(0, 1, 4, 2, 3).reshape(B, Lp, dilation, H)[:, :L].reshape(B, S, H)
    num = num.reshape(B, Lp, dilation, H, Dh)[:, :L].reshape(B, S, H, Dh)
    return to_seq(m), to_seq(den), num


def dilated_branch_sample(q, k_all, v_all, slopes, window, dilation):
    B, T, H, Dh = q.shape
    u0 = k_all.shape[1] - T
    w = window // dilation
    dist = jnp.arange(w + 1) * dilation
    u = u0 + jnp.arange(T)[:, None] - dist[None, :]
    valid = u >= 0
    uc = jnp.maximum(u, 0)
    kg = k_all[:, uc]
    vg = v_all[:, uc]
    s = jnp.einsum('bthe,btjhe->bthj', q, kg).astype(jnp.float32) * (Dh ** -0.5)
    s = s - slopes[:, None] * dist.astype(jnp.float32)[None, :]
    s = jnp.where(valid[None, :, None, :], s, -jnp.inf)
    m = jnp.max(s, axis=-1)
    p = jnp.exp(s - m[..., None])
    den = jnp.sum(p, axis=-1)
    num = jnp.einsum('bthj,btjhe->bthe', p, vg.astype(jnp.float32))
    return m, den, num


def merge_by_denominator(parts):
    m = functools.reduce(jnp.maximum, [pt[0] for pt in parts])
    scales = [jnp.exp(pt[0] - m) for pt in parts]
    den = functools.reduce(jnp.add, [sc * pt[1] for sc, pt in zip(scales, parts)])
    num = functools.reduce(jnp.add, [sc[..., None] * pt[2] for sc, pt in zip(scales, parts)])
    return num / den[..., None]


def mem_kv(mem, g, w_ck, w_cv):
    B = mem.shape[0]
    mn = rmsnorm(mem, g)
    return ((mn @ w_ck).reshape(B, N_MEM, N_HEADS_X, HEAD_DIM_X),
            (mn @ w_cv).reshape(B, N_MEM, N_HEADS_X, HEAD_DIM_X))


def cross_attend(h, mk, mv, w_cq, w_co):
    B, T, _ = h.shape
    q = (h @ w_cq).reshape(B, T, N_HEADS_X, HEAD_DIM_X)
    s = jnp.einsum('bthe,bmhe->bhtm', q, mk).astype(jnp.float32) * (HEAD_DIM_X ** -0.5)
    p = jax.nn.softmax(s, axis=-1)
    o = jnp.einsum('bhtm,bmhe->bthe', p, mv.astype(jnp.float32)).reshape(B, T, N_HEADS_X * HEAD_DIM_X)
    return o.astype(h.dtype) @ w_co


def setup_inputs(seed: int = 0) -> dict:
    key = jax.random.key(seed)
    ks = iter(jax.random.split(key, 48))
    nrm = lambda shape, scale: jax.random.normal(next(ks), shape, jnp.float32) * scale
    gain = lambda shape: 1.0 + nrm(shape, 0.02)
    w_buf = min(WIN_MAX, PAST_LEN)
    L = DEPTH
    return {
        'x_prompt': nrm((BATCH, SEQ, D_MODEL), 1.0),
        'x_sample': nrm((DEC_BATCH, DEC_SEQ, D_MODEL), 1.0),
        'mem_prompt': nrm((BATCH, N_MEM, D_MODEL), 1.0),
        'cache_win_k': nrm((L, DEC_BATCH, w_buf, N_HEADS_A, HEAD_DIM), 1.0),
        'cache_win_v': nrm((L, DEC_BATCH, w_buf, N_HEADS_A, HEAD_DIM), 1.0),
        'cache_conv': nrm((L, DEC_BATCH, CONV_WIDTH - 1, WIDTH_B), 0.5),
        'cache_mem_k': nrm((L, DEC_BATCH, N_MEM, N_HEADS_X, HEAD_DIM_X), 1.0),
        'cache_mem_v': nrm((L, DEC_BATCH, N_MEM, N_HEADS_X, HEAD_DIM_X), 1.0),
        'ffn1_norm': gain((L, D_MODEL)),
        'ffn1_gate': nrm((L, D_MODEL, D_FF), D_MODEL ** -0.5),
        'ffn1_up': nrm((L, D_MODEL, D_FF), D_MODEL ** -0.5),
        'ffn1_down': nrm((L, D_FF, D_MODEL), D_FF ** -0.5),
        'mix_norm': gain((L, D_MODEL)),
        'w_in': nrm((L, D_MODEL, 3 * WIDTH_A + 2 * WIDTH_B), D_MODEL ** -0.5),
        'conv_w': nrm((L, CONV_WIDTH, WIDTH_B), CONV_WIDTH ** -0.5),
        'conv_b': nrm((L, WIDTH_B), 0.02),
        'conv_ln_g': gain((L, WIDTH_B)),
        'conv_ln_b': nrm((L, WIDTH_B), 0.02),
        'w_out': nrm((L, MIX_WIDTH, D_MODEL), MIX_WIDTH ** -0.5),
        'xattn_norm': gain((L, D_MODEL)),
        'mem_norm': gain((L, D_MODEL)),
        'w_cq': nrm((L, D_MODEL, N_HEADS_X * HEAD_DIM_X), D_MODEL ** -0.5),
        'w_ck': nrm((L, D_MODEL, N_HEADS_X * HEAD_DIM_X), D_MODEL ** -0.5),
        'w_cv': nrm((L, D_MODEL, N_HEADS_X * HEAD_DIM_X), D_MODEL ** -0.5),
        'w_co': nrm((L, N_HEADS_X * HEAD_DIM_X, D_MODEL), (N_HEADS_X * HEAD_DIM_X) ** -0.5),
        'ffn2_norm': gain((L, D_MODEL)),
        'ffn2_gate': nrm((L, D_MODEL, D_FF), D_MODEL ** -0.5),
        'ffn2_up': nrm((L, D_MODEL, D_FF), D_MODEL ** -0.5),
        'ffn2_down': nrm((L, D_FF, D_MODEL), D_FF ** -0.5),
        'final_norm': gain((D_MODEL,)),
    }


def reference(x_prompt, x_sample, mem_prompt, cache_win_k, cache_win_v, cache_conv, cache_mem_k, cache_mem_v,
              ffn1_norm, ffn1_gate, ffn1_up, ffn1_down, mix_norm, w_in, conv_w, conv_b, conv_ln_g, conv_ln_b,
              w_out, xattn_norm, mem_norm, w_cq, w_ck, w_cv, w_co, ffn2_norm, ffn2_gate, ffn2_up, ffn2_down,
              final_norm):
    slopes = alibi_slopes(N_HEADS_A)
    yp, ys = x_prompt, x_sample
    Bp, S, _ = x_prompt.shape
    Bs, T, _ = x_sample.shape
    keep = min(WIN_MAX, S)
    pk, pv, pc, pmk, pmv, sk, sv, sc = [], [], [], [], [], [], [], []
    for l in range(DEPTH):
        yp = ffn_half_step(yp, ffn1_norm[l], ffn1_gate[l], ffn1_up[l], ffn1_down[l])
        q, k, v, u = project_in(rmsnorm(yp, mix_norm[l]), w_in[l])
        o_a = merge_by_denominator([dilated_branch_prompt(q, k, v, slopes, wdw, dil)
                                    for (wdw, dil) in DILATED_BRANCHES])
        u_ext = jnp.pad(u, ((0, 0), (CONV_WIDTH - 1, 0), (0, 0)))
        o_b = conv_branch(u_ext, conv_w[l], conv_b[l], conv_ln_g[l], conv_ln_b[l])
        yp = yp + jnp.concatenate([o_a.reshape(Bp, S, WIDTH_A).astype(yp.dtype), o_b], axis=-1) @ w_out[l]
        mk, mv = mem_kv(mem_prompt, mem_norm[l], w_ck[l], w_cv[l])
        yp = yp + cross_attend(rmsnorm(yp, xattn_norm[l]), mk, mv, w_cq[l], w_co[l])
        yp = ffn_half_step(yp, ffn2_norm[l], ffn2_gate[l], ffn2_up[l], ffn2_down[l])
        pk.append(k[:, S - keep:])
        pv.append(v[:, S - keep:])
        pc.append(u[:, S - (CONV_WIDTH - 1):])
        pmk.append(mk)
        pmv.append(mv)
        ys = ffn_half_step(ys, ffn1_norm[l], ffn1_gate[l], ffn1_up[l], ffn1_down[l])
        q, k, v, u = project_in(rmsnorm(ys, mix_norm[l]), w_in[l])
        k_all = jnp.concatenate([cache_win_k[l].astype(k.dtype), k], axis=1)
        v_all = jnp.concatenate([cache_win_v[l].astype(v.dtype), v], axis=1)
        o_a = merge_by_denominator([dilated_branch_sample(q, k_all, v_all, slopes, wdw, dil)
                                    for (wdw, dil) in DILATED_BRANCHES])
        u_ext = jnp.concatenate([cache_conv[l].astype(u.dtype), u], axis=1)
        o_b = conv_branch(u_ext, conv_w[l], conv_b[l], conv_ln_g[l], conv_ln_b[l])
        ys = ys + jnp.concatenate([o_a.reshape(Bs, T, WIDTH_A).astype(ys.dtype), o_b], axis=-1) @ w_out[l]
        ys = ys + cross_attend(rmsnorm(ys, xattn_norm[l]), cache_mem_k[l], cache_mem_v[l], w_cq[l], w_co[l])
        ys = ffn_half_step(ys, ffn2_norm[l], ffn2_gate[l], ffn2_up[l], ffn2_down[l])
        sk.append(k)
        sv.append(v)
        sc.append(u_ext[:, u_ext.shape[1] - (CONV_WIDTH - 1):])
    y_prompt = rmsnorm(yp, final_norm)
    y_sample = rmsnorm(ys, final_norm)
    return (y_prompt, y_sample, jnp.stack(pk), jnp.stack(pv), jnp.stack(pc), jnp.stack(pmk), jnp.stack(pmv),
            jnp.stack(sk), jnp.stack(sv), jnp.stack(sc))
```

```cpp
#include <hip/hip_runtime.h>
#include <cstdio>
#include <cstdint>
namespace pg8 {
#define PG8_LAS __attribute__((address_space(3)))
typedef unsigned short bf16_t;
typedef short bf16x8 __attribute__((ext_vector_type(8)));
typedef float f32x4 __attribute__((ext_vector_type(4)));
typedef unsigned u32x4 __attribute__((ext_vector_type(4)));
constexpr int BM = 256, BK = 64, HALF = 128, HTB = HALF * BK * 2  , STAGE_BYTES = 8 * HTB, NXCD = 8, WGM = 8;

__host__ __device__ __forceinline__ int lds_byte(int r, int c) { const int st = (r >> 4) * 2 + (c >> 5), rr = r & 15, cc = c & 31, ob = rr * 64 + cc * 2; return st * 1024 + (ob ^ (((ob >> 9) & 1) << 5)); }
__host__ __device__ __forceinline__ void stage_rc(int b, int& R, int& C) { const int st = b / 1024, sb = b % 1024, swz = sb ^ (((sb >> 9) & 1) << 5); R = (st >> 1) * 16 + swz / 64; C = (st & 1) * 32 + (swz % 64) / 2; }
__host__ __device__ __forceinline__ int perm32(int rho) { const int n = rho >> 4, i = rho & 15; return 8 * (i >> 2) + 4 * n + (i & 3); }

struct Unit { int pm, pn; };
struct Gemm { const bf16_t* A; const bf16_t* Bt; int M, N, K; };

struct StaticOrder {
    int nM, nN, nwg, G, c;
    __host__ __device__ void init(int M, int N, int G_, int c_) { nM = M / BM; nN = N / BM; nwg = nM * nN; G = G_; c = c_; }
    __host__ __device__ bool next(int i, Unit& u) const {
        const long L = (long)i * G + c; if (L >= nwg) return false;
        int wgid = (int)L; { const int q = nwg / NXCD, r = nwg % NXCD, xcd = wgid % NXCD, off = wgid / NXCD; wgid = (xcd < r ? xcd * (q + 1) : r * (q + 1) + (xcd - r) * q) + off; }
        const int nig = WGM * nN, gid = wgid / nig, fm = gid * WGM, gsz = (nM - fm) < WGM ? (nM - fm) : WGM;
        u.pm = fm + ((wgid % nig) % gsz); u.pn = (wgid % nig) / gsz; return true;
    }
    __device__ __forceinline__ void a_ready(const Unit&) const {}
    __device__ __forceinline__ void done(const Unit&) const {}
};

__device__ __forceinline__ unsigned cvt_pk_bf16(float lo, float hi) { unsigned r; asm volatile("v_cvt_pk_bf16_f32 %0, %1, %2" : "=v"(r) : "v"(lo), "v"(hi)); return r; }
template <class Epi, class Sched, bool ALIGN_EPI = false, bool SP2 = false>
__device__ __forceinline__ void gemm_phase(PG8_LAS unsigned char* lds, const Gemm g, const Sched& S, const Epi& E) {
    const int tid = threadIdx.x, wid = __builtin_amdgcn_readfirstlane(tid >> 6), lane = tid & 63, wr = wid >> 2, wc = wid & 3, fr = lane & 15, fq = lane >> 4;
    const int K = g.K, nt = K / BK;
    unsigned voffA[2], voffB[2];
#pragma unroll
    for (int i = 0; i < 2; ++i) { int R, C; stage_rc(tid * 16 + i * 8192, R, C); const int Rb = Epi::PERM ? ((R & ~31) + perm32(R & 31)) : R;
        voffA[i] = (unsigned)(R * K + C) * 2u; voffB[i] = (unsigned)(Rb * K + C) * 2u; }
    const size_t kstep = (size_t)(BK * 2);
    const size_t hstep = (size_t)HALF * K * 2;
    const size_t tstep = 2 * hstep;
    const unsigned ldsw = (unsigned)wid * 1024u;
    const int aoff = lds_byte(wr * 64 + fr, fq * 8), boff = lds_byte(wc * 32 + fr, fq * 8);
#define PG8_SA(b, h) (((b) * 2 + (h)) * HTB)
#define PG8_SB(b, h) ((4 + (b) * 2 + (h)) * HTB)
#define PG8_STAGE(bufoff, gbase, voff) do { _Pragma("unroll") for (int _i = 0; _i < 2; ++_i) \
        __builtin_amdgcn_global_load_lds((const unsigned*)((const char*)(gbase) + (voff)[_i]), (PG8_LAS unsigned*)(lds + (bufoff) + ldsw + _i * 8192), 16, 0, 0); } while (0)
#define PG8_LDA(dst, b, h) do { _Pragma("unroll") for (int m = 0; m < 4; ++m) _Pragma("unroll") for (int k = 0; k < 2; ++k) dst[m][k] = *(const PG8_LAS bf16x8*)(lds + PG8_SA(b, h) + aoff + m * 2048 + k * 1024); } while (0)
#define PG8_LDB(dst, b, h) do { _Pragma("unroll") for (int n = 0; n < 2; ++n) _Pragma("unroll") for (int k = 0; k < 2; ++k) dst[n][k] = *(const PG8_LAS bf16x8*)(lds + PG8_SB(b, h) + boff + n * 2048 + k * 1024); } while (0)
#define PG8_MMA(ai, bj, At, Bt) do { __builtin_amdgcn_s_setprio(1); _Pragma("unroll") for (int m = 0; m < 4; ++m) _Pragma("unroll") for (int n = 0; n < 2; ++n) _Pragma("unroll") for (int k = 0; k < 2; ++k) \
        acc[ai][bj][m][n] = __builtin_amdgcn_mfma_f32_16x16x32_bf16(Bt[n][k], At[m][k], acc[ai][bj][m][n], 0, 0, 0); __builtin_amdgcn_s_setprio(0); } while (0)
#define PG8_WAIT_V(n) asm volatile("s_waitcnt vmcnt(" #n ")" ::: "memory")
#define PG8_WAIT_L(n) asm volatile("s_waitcnt lgkmcnt(" #n ")" ::: "memory")
#define PG8_BAR __builtin_amdgcn_s_barrier()
#define PG8_SCHED __builtin_amdgcn_sched_barrier(0)
    Unit cur, nxt; int ui = 0;
    if (!S.next(0, cur)) return;
    f32x4 acc[2][2][4][2];
#pragma unroll
    for (int a = 0; a < 2; ++a)
#pragma unroll
        for (int b = 0; b < 2; ++b)
#pragma unroll
            for (int m = 0; m < 4; ++m)
#pragma unroll
                for (int n = 0; n < 2; ++n) acc[a][b][m][n] = (f32x4){0.f, 0.f, 0.f, 0.f};
    bf16x8 At[4][2], B0[2][2], B1[2][2];
    const char* cA = (const char*)g.A + (size_t)cur.pm * tstep; const char* cB = (const char*)g.Bt + (size_t)cur.pn * tstep;
    S.a_ready(cur);
    if constexpr (SP2) {
        PG8_STAGE(PG8_SB(0, 0), cB, voffB); PG8_STAGE(PG8_SB(0, 1), cB + hstep, voffB); PG8_STAGE(PG8_SA(0, 0), cA, voffA); PG8_STAGE(PG8_SA(0, 1), cA + hstep, voffA);
        if (wr == 1) PG8_BAR;
        PG8_WAIT_V(2); PG8_BAR;
        PG8_STAGE(PG8_SB(1, 0), cB + kstep, voffB); PG8_STAGE(PG8_SA(1, 0), cA + kstep, voffA); PG8_STAGE(PG8_SB(1, 1), cB + hstep + kstep, voffB);
        PG8_WAIT_V(6); PG8_BAR;
    } else {
        PG8_STAGE(PG8_SB(0, 0), cB, voffB); PG8_STAGE(PG8_SA(0, 0), cA, voffA); PG8_STAGE(PG8_SB(0, 1), cB + hstep, voffB); PG8_STAGE(PG8_SA(0, 1), cA + hstep, voffA);
        if (wr == 1) PG8_BAR;
        PG8_WAIT_V(4); PG8_BAR;
        PG8_STAGE(PG8_SB(1, 0), cB + kstep, voffB); PG8_STAGE(PG8_SA(1, 0), cA + kstep, voffA); PG8_STAGE(PG8_SB(1, 1), cB + hstep + kstep, voffB);
        PG8_WAIT_V(6); PG8_BAR;
    }
    for (;;) {
        const bool has_next = S.next(ui + 1, nxt);
        const char* nA = has_next ? (const char*)g.A + (size_t)nxt.pm * tstep : cA; const char* nB = has_next ? (const char*)g.Bt + (size_t)nxt.pn * tstep : cB;
        for (int t = 0; t < nt; t += 2) {
            const bool last = (t == nt - 2);
            const char* a1 = cA + (size_t)(t + 1) * kstep;
            const char* a2 = last ? nA : cA + (size_t)(t + 2) * kstep; const char* b2 = last ? nB : cB + (size_t)(t + 2) * kstep;
            const char* a3 = a2 + kstep; const char* b3 = b2 + kstep;
            if (last && has_next) S.a_ready(nxt);
            if constexpr (SP2) {
            PG8_LDB(B0, 0, 0); PG8_LDB(B1, 0, 1); PG8_SCHED; PG8_LDA(At, 0, 0); PG8_STAGE(PG8_SA(1, 1), a1 + hstep, voffA);
            PG8_WAIT_V(8); PG8_WAIT_L(0); PG8_BAR; PG8_MMA(0, 0, At, B0); PG8_MMA(0, 1, At, B1); PG8_BAR; PG8_SCHED;
            PG8_LDA(At, 0, 1); PG8_STAGE(PG8_SB(0, 0), b2, voffB); PG8_STAGE(PG8_SB(0, 1), b2 + hstep, voffB); PG8_STAGE(PG8_SA(0, 0), a2, voffA);
            PG8_WAIT_V(8); PG8_WAIT_L(0); PG8_BAR; PG8_MMA(1, 0, At, B0); PG8_MMA(1, 1, At, B1); PG8_BAR; PG8_SCHED;
            PG8_LDB(B0, 1, 0); PG8_LDB(B1, 1, 1); PG8_SCHED; PG8_LDA(At, 1, 0); PG8_STAGE(PG8_SA(0, 1), a2 + hstep, voffA);
            PG8_WAIT_V(8); PG8_WAIT_L(0); PG8_BAR; PG8_MMA(0, 0, At, B0); PG8_MMA(0, 1, At, B1); PG8_BAR; PG8_SCHED;
            PG8_LDA(At, 1, 1); PG8_STAGE(PG8_SB(1, 0), b3, voffB); PG8_STAGE(PG8_SB(1, 1), b3 + hstep, voffB); PG8_STAGE(PG8_SA(1, 0), a3, voffA);
            PG8_WAIT_V(8); PG8_WAIT_L(0); PG8_BAR; PG8_MMA(1, 0, At, B0); PG8_MMA(1, 1, At, B1); PG8_BAR; PG8_SCHED;
            } else {
            PG8_LDB(B0, 0, 0); PG8_SCHED; PG8_LDA(At, 0, 0); PG8_STAGE(PG8_SA(1, 1), a1 + hstep, voffA);
            PG8_WAIT_L(8); PG8_BAR; PG8_WAIT_L(0); PG8_MMA(0, 0, At, B0); PG8_BAR; PG8_SCHED;
            PG8_LDB(B1, 0, 1); PG8_STAGE(PG8_SB(0, 0), b2, voffB);
            PG8_BAR; PG8_WAIT_L(0); PG8_MMA(0, 1, At, B1); PG8_BAR;
            PG8_LDA(At, 0, 1); PG8_STAGE(PG8_SA(0, 0), a2, voffA);
            PG8_BAR; PG8_WAIT_L(0); PG8_MMA(1, 0, At, B0); PG8_BAR; PG8_SCHED;
            PG8_STAGE(PG8_SB(0, 1), b2 + hstep, voffB);
            PG8_WAIT_V(6); PG8_BAR; PG8_MMA(1, 1, At, B1); PG8_BAR;
            PG8_LDB(B0, 1, 0); PG8_SCHED; PG8_LDA(At, 1, 0); PG8_STAGE(PG8_SA(0, 1), a2 + hstep, voffA);
            PG8_WAIT_L(8); PG8_BAR; PG8_WAIT_L(0); PG8_MMA(0, 0, At, B0); PG8_BAR; PG8_SCHED;
            PG8_LDB(B1, 1, 1); PG8_STAGE(PG8_SB(1, 0), b3, voffB);
            PG8_BAR; PG8_WAIT_L(0); PG8_MMA(0, 1, At, B1); PG8_BAR;
            PG8_LDA(At, 1, 1); PG8_STAGE(PG8_SA(1, 0), a3, voffA);
            PG8_BAR; PG8_WAIT_L(0); PG8_MMA(1, 0, At, B0); PG8_BAR; PG8_SCHED;
            PG8_STAGE(PG8_SB(1, 1), b3 + hstep, voffB);
            PG8_WAIT_V(6); PG8_BAR; PG8_MMA(1, 1, At, B1); PG8_BAR;
            }
        }
        if constexpr (ALIGN_EPI) { if (wr == 0) PG8_BAR; }
        if constexpr (!Epi::AFTER_DRAIN) { E(acc, cur, wr, wc, fr, fq); S.done(cur); }
        if (!has_next) break;
#pragma unroll
        for (int a = 0; a < 2; ++a)
#pragma unroll
            for (int b = 0; b < 2; ++b)
#pragma unroll
                for (int m = 0; m < 4; ++m)
#pragma unroll
                    for (int n = 0; n < 2; ++n) acc[a][b][m][n] = (f32x4){0.f, 0.f, 0.f, 0.f};
        cur = nxt; cA = nA; cB = nB; ++ui;
        if constexpr (ALIGN_EPI) { if (wr == 1) PG8_BAR; }
    }
    PG8_WAIT_V(0);
    if constexpr (!ALIGN_EPI) { if (wr == 0) PG8_BAR; }
    PG8_BAR;
    if constexpr (Epi::AFTER_DRAIN) { E.fused(acc, cur, wr, wc, fr, fq, lds, wid, lane); S.done(cur); }
#undef PG8_SA
#undef PG8_SB
#undef PG8_STAGE
#undef PG8_LDA
#undef PG8_LDB
#undef PG8_MMA
#undef PG8_WAIT_V
#undef PG8_WAIT_L
#undef PG8_BAR
#undef PG8_SCHED
}
}

#define LAS __attribute__((address_space(3)))
typedef unsigned short bf16_t;
typedef short bf16x8 __attribute__((ext_vector_type(8)));
typedef short s16x4 __attribute__((ext_vector_type(4)));
typedef float f32x4 __attribute__((ext_vector_type(4)));
typedef float f32x2 __attribute__((ext_vector_type(2)));
typedef unsigned u32x4 __attribute__((ext_vector_type(4)));
typedef unsigned u32x2 __attribute__((ext_vector_type(2)));

constexpr int DM = 1024, NP = 32768, NS = 256, MT = NP + NS, SEQ = 2048, FF = 2816, NMEMROWS = 4096;
constexpr float EPS = 1e-6f, LOG2E = 1.4426950408889634f;
constexpr int NWAVES = 8, NTHREADS = 512;
constexpr int LDS_BYTES = 147456;
constexpr size_t O_Y = 0, O_YS = 33554432, O_WKP = 33816576, O_WVP = 50593792, O_CP = 67371008, O_MKP = 67616768, O_MVP = 71811072,
                 O_WKS = 76005376, O_WVS = 76136448, O_CS = 76267520, O_END = 76759040;
constexpr size_t MiB = 1u << 20;
constexpr size_t WS_SSQ0 = 0, WS_SSQM = 256 * 1024, WS_SSQ = 512 * 1024;
constexpr size_t WS_BAR = 1536 * 1024;
constexpr size_t WS_WGU1 = 2 * MiB, WS_WD1 = 14 * MiB, WS_WIN = 20 * MiB, WS_WOUT = 26 * MiB, WS_WCQ = 28 * MiB, WS_WCKV = 30 * MiB, WS_WCO = 34 * MiB,
                 WS_WGU2 = 36 * MiB, WS_WD2 = 48 * MiB;
constexpr size_t WS_XB = 56 * MiB, WS_MEMB = 122 * MiB, WS_MKB = 130 * MiB, WS_MVB = 138 * MiB;
constexpr size_t WS_QB = 148 * MiB, WS_KB = 181 * MiB, WS_VB = 214 * MiB, WS_UB = 247 * MiB, WS_MIX = 280 * MiB, WS_QX = 345 * MiB, WS_OX = 410 * MiB, WS_END = 485 * MiB;
static_assert(WS_VB - WS_KB == WS_KB - WS_QB, "QB|KB|VB spacing");
constexpr size_t WS_SSQP = 476 * MiB, WS_SSQS = 484 * MiB;
constexpr size_t WS_ACT = 148 * MiB;

struct Args { const float* in[30]; float* out; unsigned char* ws; int ph_lo, ph_hi; };

__device__ __forceinline__ unsigned pk2(float lo, float hi) { return pg8::cvt_pk_bf16(lo, hi); }
__device__ __forceinline__ float bflo(unsigned u) { return __uint_as_float(u << 16); }
__device__ __forceinline__ float bfhi(unsigned u) { return __uint_as_float(u & 0xffff0000u); }
__device__ __forceinline__ float fexp2(float x) { return __builtin_amdgcn_exp2f(x); }
__device__ __forceinline__ float frcp(float x) { return __builtin_amdgcn_rcpf(x); }
__device__ __forceinline__ float silu_f(float x) { return x * frcp(1.0f + fexp2(-x * LOG2E)); }
__device__ __forceinline__ float sigm_f(float x) { return frcp(1.0f + fexp2(-x * LOG2E)); }
__device__ __forceinline__ float wave_sum(float v) {
#pragma unroll
    for (int o = 1; o < 64; o <<= 1) v += __shfl_xor(v, o);
    return v;
}
__device__ __forceinline__ float rstd_of(float ssq) { return __builtin_amdgcn_rsqf(ssq * (1.0f / 1024.0f) + EPS); }

template <bool PART> __device__ __forceinline__ float rowss4(const float* p, int row, int fq) {
    if (!PART) return p[row];
    const f32x4 a = ((const f32x4*)(p + (size_t)row * 16))[fq];
    float v = (a[0] + a[1]) + (a[2] + a[3]);
    v += __shfl_xor(v, 16); v += __shfl_xor(v, 32);
    return v;
}
template <bool PART> __device__ __forceinline__ float rowss(const float* p, int row) {
    if (!PART) return p[row];
    const f32x4* q = (const f32x4*)(p + (size_t)row * 16); const f32x4 a = q[0], b = q[1], c = q[2], d = q[3];
    return ((a[0] + a[1]) + (a[2] + a[3])) + ((b[0] + b[1]) + (b[2] + b[3])) + ((c[0] + c[1]) + (c[2] + c[3])) + ((d[0] + d[1]) + (d[2] + d[3]));
}
__device__ __forceinline__ float samp_ss(const float* ps, int rr, int fq) {
    const f32x4* q = (const f32x4*)(ps + (size_t)rr * 128 + fq * 32); f32x4 t = (f32x4){0.f, 0.f, 0.f, 0.f};
#pragma unroll
    for (int i = 0; i < 8; ++i) t = t + q[i];
    float v = (t[0] + t[1]) + (t[2] + t[3]);
    v += __shfl_xor(v, 16); v += __shfl_xor(v, 32);
    return v;
}
using pg8::Unit;
template <bool PART> struct EpiGU {
    static constexpr bool PERM = true, AFTER_DRAIN = false;
    bf16_t* ACT; const float* ssq;
    __device__ __forceinline__ void operator()(const f32x4 (&acc)[2][2][4][2], const Unit& u, int wr, int wc, int fr, int fq) const {
        const int row0 = u.pm * 256 + wr * 64 + fr; const int col0 = u.pn * 128 + wc * 32 + 8 * fq;
        float rsv[8];
#pragma unroll
        for (int i = 0; i < 8; ++i) rsv[i] = rowss4<PART>(ssq, row0 + (i >> 2) * 128 + (i & 3) * 16, fq);
#pragma unroll
        for (int ai = 0; ai < 2; ++ai)
#pragma unroll
            for (int m = 0; m < 4; ++m) {
                const int row = row0 + ai * 128 + m * 16; const float rs = rstd_of(rsv[ai * 4 + m]);
                float v[8];
#pragma unroll
                for (int n = 0; n < 2; ++n)
#pragma unroll
                    for (int e = 0; e < 4; ++e) { const float g = acc[ai][0][m][n][e] * rs, up = acc[ai][1][m][n][e] * rs; v[n * 4 + e] = silu_f(g) * up; }
                u32x4 w; w.x = pk2(v[0], v[1]); w.y = pk2(v[2], v[3]); w.z = pk2(v[4], v[5]); w.w = pk2(v[6], v[7]);
                *(u32x4*)(ACT + (size_t)row * FF + col0) = w;
            }
    }
};
template <bool BASE_F32, bool OUT_F32> struct EpiRes {
    static constexpr bool PERM = true, AFTER_DRAIN = false;
    const float* base_p; float* X; bf16_t* XB; float* ssq; float scale;
    __device__ __forceinline__ void operator()(const f32x4 (&acc)[2][2][4][2], const Unit& u, int wr, int wc, int fr, int fq) const {
        const int row0 = u.pm * 256 + wr * 64 + fr; const int col0 = u.pn * 256 + wc * 32 + 8 * fq;
#pragma unroll
        for (int ai = 0; ai < 2; ++ai) {
            f32x4 pre[4][2][2];
#pragma unroll
            for (int m = 0; m < 4; ++m)
#pragma unroll
                for (int bj = 0; bj < 2; ++bj) {
                    const size_t off = (size_t)(row0 + ai * 128 + m * 16) * DM + col0 + bj * 128;
                    if (BASE_F32) { pre[m][bj][0] = *(const f32x4*)(base_p + off); pre[m][bj][1] = *(const f32x4*)(base_p + off + 4); }
                    else { const u32x4 w = *(const u32x4*)(XB + off); pre[m][bj][0] = (f32x4){bflo(w.x), bfhi(w.x), bflo(w.y), bfhi(w.y)}; pre[m][bj][1] = (f32x4){bflo(w.z), bfhi(w.z), bflo(w.w), bfhi(w.w)}; }
                }
            asm volatile("" ::: "memory");
#pragma unroll
            for (int m = 0; m < 4; ++m) {
                const int row = row0 + ai * 128 + m * 16;
                float sq = 0.f;
#pragma unroll
                for (int bj = 0; bj < 2; ++bj) {
                    const size_t off = (size_t)row * DM + col0 + bj * 128;
                    const f32x4 v0 = pre[m][bj][0] + acc[ai][bj][m][0] * scale, v1 = pre[m][bj][1] + acc[ai][bj][m][1] * scale;
                    if (OUT_F32) { *(f32x4*)(X + off) = v0; *(f32x4*)(X + off + 4) = v1; }
                    else { u32x4 w; w.x = pk2(v0[0], v0[1]); w.y = pk2(v0[2], v0[3]); w.z = pk2(v1[0], v1[1]); w.w = pk2(v1[2], v1[3]); *(u32x4*)(XB + off) = w; }
                    sq += ((v0[0] * v0[0] + v0[1] * v0[1]) + (v0[2] * v0[2] + v0[3] * v0[3])) + ((v1[0] * v1[0] + v1[1] * v1[1]) + (v1[2] * v1[2] + v1[3] * v1[3]));
                }
                sq += __shfl_xor(sq, 16); sq += __shfl_xor(sq, 32);
                if (fq == 0) ssq[(size_t)row * 16 + u.pn * 4 + wc] = sq;
            }
        }
    }
};
struct EpiWin {
    static constexpr bool PERM = true, AFTER_DRAIN = false;
    bf16_t *QB, *KB, *VB, *UB; float* out; const float* ssq;
    __device__ __forceinline__ void operator()(const f32x4 (&acc)[2][2][4][2], const Unit& u, int wr, int wc, int fr, int fq) const {
        const int row0 = u.pm * 256 + wr * 64 + fr; const int pn = u.pn;
        const bool samp = u.pm >= 128;
        float rsv[8];
#pragma unroll
        for (int i = 0; i < 8; ++i) rsv[i] = rowss4<true>(ssq, row0 + (i >> 2) * 128 + (i & 3) * 16, fq);
        if (pn < 6) {
            const int sec = pn >> 1;
            bf16_t* B16 = QB + (size_t)sec * ((WS_KB - WS_QB) / 2) + (pn & 1) * 256 + wc * 32 + 8 * fq;
            const size_t fsec = sec ? (size_t)(sec - 1) : 0;
            float* fo = out + (samp ? (O_WKS - (size_t)NP * 512) + fsec * (O_WVS - O_WKS) : O_WKP + fsec * (O_WVP - O_WKP)) + (pn & 1) * 256 + wc * 32 + 8 * fq;
            const float qs = sec == 0 ? (0.125f * LOG2E) : 1.0f;
#pragma unroll
            for (int ai = 0; ai < 2; ++ai)
#pragma unroll
                for (int m = 0; m < 4; ++m) {
                    const int row = row0 + ai * 128 + m * 16; const float sc = rstd_of(rsv[ai * 4 + m]) * qs;
#pragma unroll
                    for (int bj = 0; bj < 2; ++bj) {
                        const int col = bj * 128;
                        const f32x4 v0 = acc[ai][bj][m][0] * sc, v1 = acc[ai][bj][m][1] * sc;
                        if (sec) { *(f32x4*)(fo + (size_t)row * 512 + col) = v0; *(f32x4*)(fo + (size_t)row * 512 + col + 4) = v1; }
                        u32x4 w; w.x = pk2(v0[0], v0[1]); w.y = pk2(v0[2], v0[3]); w.z = pk2(v1[0], v1[1]); w.w = pk2(v1[2], v1[3]); *(u32x4*)(B16 + (size_t)row * 512 + col) = w;
                    }
                }
        } else {
            const int c0 = (pn - 6) * 128 + wc * 32 + 8 * fq;
#pragma unroll
            for (int ai = 0; ai < 2; ++ai)
#pragma unroll
                for (int m = 0; m < 4; ++m) {
                    const int row = row0 + ai * 128 + m * 16; const float rs = rstd_of(rsv[ai * 4 + m]);
                    float* fo = nullptr;
                    if (!samp) { const int sq = row & 2047; if (sq >= 2018) fo = out + O_CP + ((size_t)(row >> 11) * 30 + (sq - 2018)) * 512 + c0; }
                    else { const int rr = row - NP; fo = out + O_CS + ((size_t)(rr >> 3) * 30 + 22 + (rr & 7)) * 512 + c0; }
                    f32x4 v[2];
#pragma unroll
                    for (int n = 0; n < 2; ++n) {
                        const f32x4 a = acc[ai][0][m][n] * rs, g = acc[ai][1][m][n] * rs;
#pragma unroll
                        for (int e = 0; e < 4; ++e) v[n][e] = a[e] * sigm_f(g[e]);
                    }
                    if (fo) { *(f32x4*)(fo) = v[0]; *(f32x4*)(fo + 4) = v[1]; }
                    u32x4 w; w.x = pk2(v[0][0], v[0][1]); w.y = pk2(v[0][2], v[0][3]); w.z = pk2(v[1][0], v[1][1]); w.w = pk2(v[1][2], v[1][3]); *(u32x4*)(UB + (size_t)row * 512 + c0) = w;
                }
        }
    }
};
struct EpiCQ {
    static constexpr bool PERM = true, AFTER_DRAIN = false;
    bf16_t* O; const float* ssq; float scale;
    __device__ __forceinline__ void operator()(const f32x4 (&acc)[2][2][4][2], const Unit& u, int wr, int wc, int fr, int fq) const {
        const int row0 = u.pm * 256 + wr * 64 + fr; const int col0 = u.pn * 256 + wc * 32 + 8 * fq;
        float rsv[8];
#pragma unroll
        for (int i = 0; i < 8; ++i) rsv[i] = rowss4<true>(ssq, row0 + (i >> 2) * 128 + (i & 3) * 16, fq);
#pragma unroll
        for (int ai = 0; ai < 2; ++ai)
#pragma unroll
            for (int m = 0; m < 4; ++m) {
                const int row = row0 + ai * 128 + m * 16; const float rs = rstd_of(rsv[ai * 4 + m]) * scale;
#pragma unroll
                for (int bj = 0; bj < 2; ++bj) {
                    const f32x4 v0 = acc[ai][bj][m][0] * rs, v1 = acc[ai][bj][m][1] * rs;
                    u32x4 w; w.x = pk2(v0[0], v0[1]); w.y = pk2(v0[2], v0[3]); w.z = pk2(v1[0], v1[1]); w.w = pk2(v1[2], v1[3]);
                    *(u32x4*)(O + (size_t)row * DM + col0 + bj * 128) = w;
                }
            }
    }
};
struct EpiMemKV {
    static constexpr bool PERM = true, AFTER_DRAIN = false;
    bf16_t *MKB, *MVB; float* out; const float* ssq;
    __device__ __forceinline__ void operator()(const f32x4 (&acc)[2][2][4][2], const Unit& u, int wr, int wc, int fr, int fq) const {
        const int row0 = u.pm * 256 + wr * 64 + fr; const bool isv = u.pn >= 4;
        bf16_t* B16 = isv ? MVB : MKB; float* fo = out + (isv ? O_MVP : O_MKP);
        float rsv[8];
#pragma unroll
        for (int i = 0; i < 8; ++i) rsv[i] = ssq[row0 + (i >> 2) * 128 + (i & 3) * 16];
#pragma unroll
        for (int ai = 0; ai < 2; ++ai)
#pragma unroll
            for (int m = 0; m < 4; ++m) {
                const int row = row0 + ai * 128 + m * 16; const float rs = rstd_of(rsv[ai * 4 + m]);
#pragma unroll
                for (int bj = 0; bj < 2; ++bj) {
                    const int col = (u.pn & 3) * 256 + bj * 128 + wc * 32 + 8 * fq;
                    const f32x4 v0 = acc[ai][bj][m][0] * rs, v1 = acc[ai][bj][m][1] * rs;
                    *(f32x4*)(fo + (size_t)row * DM + col) = v0; *(f32x4*)(fo + (size_t)row * DM + col + 4) = v1;
                    u32x4 w; w.x = pk2(v0[0], v0[1]); w.y = pk2(v0[2], v0[3]); w.z = pk2(v1[0], v1[1]); w.w = pk2(v1[2], v1[3]); *(u32x4*)(B16 + (size_t)row * DM + col) = w;
                }
            }
    }
};

__device__ __forceinline__ int rowmap(int mode, int n0) {
    if (mode == 1) return (n0 >> 7) * 256 + (n0 & 127);
    if (mode == 2) return (n0 >> 7) * 256 + 128 + (n0 & 127);
    if (mode == 3) { if (n0 < 1536) return n0; if (n0 < 2048) { const int c = n0 - 1536; return 1536 + (c >> 7) * 256 + (c & 127); } const int c = n0 - 2048; return 1536 + (c >> 7) * 256 + 128 + (c & 127); }
    return n0;
}
__device__ __forceinline__ void p0_transpose_item(const float* W, int K, int N, bf16_t* WT, int mode, int row_off, const float* gain, LAS float* scr, int item, int lane) {
    const int nblk = N / 32, kb = item / nblk, nb = item % nblk, k0 = 64 * kb, n0 = 32 * nb;
#pragma unroll
    for (int i = 0; i < 32; ++i) { const int kk = 2 * i + (lane >> 5); float v = W[(size_t)(k0 + kk) * N + n0 + (lane & 31)]; if (gain) v *= gain[k0 + kk]; scr[kk * 33 + (lane & 31)] = v; }
    asm volatile("s_waitcnt lgkmcnt(0)" ::: "memory");
    const int c = lane & 7; const int drow0 = row_off + rowmap(mode, n0);
#pragma unroll
    for (int j = 0; j < 4; ++j) { const int n = (lane >> 3) + 8 * j; const LAS float* s = scr + (8 * c) * 33 + n;
        u32x4 o; o.x = pk2(s[0 * 33], s[1 * 33]); o.y = pk2(s[2 * 33], s[3 * 33]); o.z = pk2(s[4 * 33], s[5 * 33]); o.w = pk2(s[6 * 33], s[7 * 33]);
        *(u32x4*)(WT + (size_t)(drow0 + n) * K + k0 + 8 * c) = o; }
    asm volatile("s_waitcnt lgkmcnt(0)" ::: "memory");
}
__device__ __forceinline__ void row_to_bf16(const float* xrow, bf16_t* orow, float* ssq_out, int lane) {
    const f32x4* xr = (const f32x4*)xrow + lane; f32x4 v[4]; float s = 0.f;
#pragma unroll
    for (int j = 0; j < 4; ++j) { v[j] = xr[64 * j]; s += (v[j][0] * v[j][0] + v[j][1] * v[j][1]) + (v[j][2] * v[j][2] + v[j][3] * v[j][3]); }
    s = wave_sum(s);
    u32x2* o8 = (u32x2*)orow + lane;
#pragma unroll
    for (int j = 0; j < 4; ++j) { u32x2 w; w.x = pk2(v[j][0], v[j][1]); w.y = pk2(v[j][2], v[j][3]); o8[64 * j] = w; }
    if (lane == 0) *ssq_out = s;
}

__device__ __forceinline__ void row2_to_bf16(const float* xa, const float* xb, bf16_t* oa, bf16_t* ob, float* sa, float* sb, int lane) {
    const f32x4* pa = (const f32x4*)xa + lane; const f32x4* pb = (const f32x4*)xb + lane; f32x4 va[4], vb[4]; float s0 = 0.f, s1 = 0.f;
#pragma unroll
    for (int j = 0; j < 4; ++j) { va[j] = pa[64 * j]; vb[j] = pb[64 * j]; }
#pragma unroll
    for (int j = 0; j < 4; ++j) { s0 += (va[j][0] * va[j][0] + va[j][1] * va[j][1]) + (va[j][2] * va[j][2] + va[j][3] * va[j][3]); s1 += (vb[j][0] * vb[j][0] + vb[j][1] * vb[j][1]) + (vb[j][2] * vb[j][2] + vb[j][3] * vb[j][3]); }
    s0 = wave_sum(s0); s1 = wave_sum(s1);
    u32x2* qa = (u32x2*)oa + lane; u32x2* qb = (u32x2*)ob + lane;
#pragma unroll
    for (int j = 0; j < 4; ++j) { u32x2 w; w.x = pk2(va[j][0], va[j][1]); w.y = pk2(va[j][2], va[j][3]); qa[64 * j] = w; u32x2 z; z.x = pk2(vb[j][0], vb[j][1]); z.y = pk2(vb[j][2], vb[j][3]); qb[64 * j] = z; }
    if (lane == 0) { *sa = s0; *sb = s1; }
}

constexpr int AT_MB_PITCH = 68;
constexpr int AT_MB_BYTES = 256 * AT_MB_PITCH * 4;
constexpr int AT_VP = 144;
constexpr int AT_VS_BYTES = 2 * 32 * AT_VP;
__device__ __forceinline__ s16x4 lds_tr(const LAS unsigned char* p) {
    typedef short v4i16_t __attribute__((ext_vector_type(4)));
    return __builtin_bit_cast(s16x4, __builtin_amdgcn_ds_read_tr16_b64_v4i16((LAS v4i16_t*)p));
}
template <int NQ> __device__ __forceinline__ void attn_tile(LAS float* MBuf, LAS unsigned char* vs, const bf16_t* QB, const bf16_t* KB, const bf16_t* VB, bf16_t* MIX,
                                                            size_t rowb, int h, int p0, int br, int r, int i0, float slope2, int lane) {
    const int fr = lane & 15, fq = lane >> 4, tq = fr >> 2, tp = fr & 3;
    const int sh = 2 * br, L = SEQ >> sh;
    int qi[NQ], qpos[NQ]; bf16x8 q0[NQ], q1[NQ]; float m_run[NQ], l_run[NQ]; f32x4 o[NQ][4];
#pragma unroll
    for (int t = 0; t < NQ; ++t) {
        qi[t] = i0 + 16 * t + fr; qpos[t] = (qi[t] << sh) + r;
        const bf16_t* qp = QB + (rowb + qpos[t]) * 512 + h * 64 + fq * 8;
        q0[t] = *(const bf16x8*)qp; q1[t] = *(const bf16x8*)(qp + 32);
        m_run[t] = -INFINITY; l_run[t] = 0.f;
#pragma unroll
        for (int dt = 0; dt < 4; ++dt) o[t][dt] = (f32x4){0.f, 0.f, 0.f, 0.f};
    }
    const bf16_t* kbase = KB + (rowb + r) * 512 + h * 64 + (lane & 7) * 8;
    const bf16_t* vbase = VB + (rowb + r) * 512 + h * 64 + (lane & 7) * 8;
    int pi_lo = (128 - i0) >> 5; pi_lo = pi_lo < 0 ? 0 : pi_lo;
    bf16x8 kf[4]; u32x4 vv[4];
#define AT_LOAD_PAIR(KF, VV, PI) do { const int kb0_ = i0 - 128 + 32 * (PI); \
        _Pragma("unroll") for (int vi_ = 0; vi_ < 4; ++vi_) { int kj_ = kb0_ + 8 * vi_ + (lane >> 3); kj_ = kj_ < 0 ? 0 : (kj_ > L - 1 ? L - 1 : kj_); \
            KF[vi_] = *(const bf16x8*)(kbase + (size_t)(kj_ << sh) * 512); VV[vi_] = *(const u32x4*)(vbase + (size_t)(kj_ << sh) * 512); } } while (0)
    AT_LOAD_PAIR(kf, vv, pi_lo);
#pragma unroll 1
    for (int pi = pi_lo; pi < 5; ++pi) {
        bf16x8 nkf[4]; u32x4 nvv[4];
        { const int pn = pi + 1 < 5 ? pi + 1 : 4; AT_LOAD_PAIR(nkf, nvv, pn); }
        const int kb0 = i0 - 128 + 32 * pi;
        { LAS unsigned char* vd = vs + (lane >> 3) * AT_VP + (lane & 7) * 16;
#pragma unroll
          for (int vi = 0; vi < 4; ++vi) { *(LAS u32x4*)(vd + 8 * vi * AT_VP) = vv[vi]; *(LAS bf16x8*)(vd + 32 * AT_VP + 8 * vi * AT_VP) = kf[vi]; } }
        bf16x8 kfr[4];
        { const LAS unsigned char* kr = vs + 32 * AT_VP + fr * AT_VP + fq * 16;
          kfr[0] = *(const LAS bf16x8*)kr; kfr[1] = *(const LAS bf16x8*)(kr + 64); kfr[2] = *(const LAS bf16x8*)(kr + 16 * AT_VP); kfr[3] = *(const LAS bf16x8*)(kr + 16 * AT_VP + 64); }
        bf16x8 pf[NQ];
#pragma unroll
        for (int t = 0; t < NQ; ++t) {
            f32x4 sa = (f32x4){0.f, 0.f, 0.f, 0.f}, sb = (f32x4){0.f, 0.f, 0.f, 0.f};
            sa = __builtin_amdgcn_mfma_f32_16x16x32_bf16(kfr[0], q0[t], sa, 0, 0, 0); sa = __builtin_amdgcn_mfma_f32_16x16x32_bf16(kfr[1], q1[t], sa, 0, 0, 0);
            sb = __builtin_amdgcn_mfma_f32_16x16x32_bf16(kfr[2], q0[t], sb, 0, 0, 0); sb = __builtin_amdgcn_mfma_f32_16x16x32_bf16(kfr[3], q1[t], sb, 0, 0, 0);
            float sc[8]; float mx = -INFINITY;
            if (pi >= 1 && pi <= 3 && kb0 >= 0) {
                const float bstep = slope2 * (float)(1 << sh);
                const float b0 = -bstep * (float)(qi[t] - kb0 - 4 * fq), b1 = b0 + 16.0f * bstep;
#pragma unroll
                for (int e = 0; e < 4; ++e) { sc[e] = sa[e] + (b0 + bstep * (float)e); sc[4 + e] = sb[e] + (b1 + bstep * (float)e); mx = fmaxf(mx, fmaxf(sc[e], sc[4 + e])); }
            } else {
#pragma unroll
            for (int e = 0; e < 4; ++e) {
                const int keya = kb0 + 4 * fq + e, da = qi[t] - keya;
                const bool va = (keya >= 0) && (da >= 0) && (da <= 128);
                sc[e] = va ? sa[e] - slope2 * (float)(da << sh) : -INFINITY;
                const int keyb = keya + 16, db = qi[t] - keyb;
                const bool vb = (keyb >= 0) && (db >= 0) && (db <= 128);
                sc[4 + e] = vb ? sb[e] - slope2 * (float)(db << sh) : -INFINITY;
                mx = fmaxf(mx, fmaxf(sc[e], sc[4 + e]));
            }
            }
            mx = fmaxf(mx, __shfl_xor(mx, 16)); mx = fmaxf(mx, __shfl_xor(mx, 32));
            const float m_new = fmaxf(m_run[t], mx);
            const float mref = (m_new == -INFINITY) ? 0.f : m_new;
            const float alpha = fexp2(m_run[t] - mref);
            float p[8]; float ps = 0.f;
#pragma unroll
            for (int e = 0; e < 8; ++e) { p[e] = fexp2(sc[e] - mref); ps += p[e]; }
            l_run[t] = l_run[t] * alpha + ps; m_run[t] = m_new;
#pragma unroll
            for (int dt = 0; dt < 4; ++dt) o[t][dt] = o[t][dt] * alpha;
            u32x4 pw; pw.x = pk2(p[0], p[1]); pw.y = pk2(p[2], p[3]); pw.z = pk2(p[4], p[5]); pw.w = pk2(p[6], p[7]);
            pf[t] = __builtin_bit_cast(bf16x8, pw);
        }
        const LAS unsigned char* tb = vs + (4 * fq + tq) * AT_VP + tp * 8;
#pragma unroll
        for (int dt = 0; dt < 4; ++dt) {
            const s16x4 a = lds_tr(tb + dt * 32), bb = lds_tr(tb + 16 * AT_VP + dt * 32);
            const bf16x8 vf = (bf16x8){a[0], a[1], a[2], a[3], bb[0], bb[1], bb[2], bb[3]};
#pragma unroll
            for (int t = 0; t < NQ; ++t) o[t][dt] = __builtin_amdgcn_mfma_f32_16x16x32_bf16(vf, pf[t], o[t][dt], 0, 0, 0);
        }
#pragma unroll
        for (int i = 0; i < 4; ++i) { kf[i] = nkf[i]; vv[i] = nvv[i]; }
    }
#undef AT_LOAD_PAIR
#pragma unroll
    for (int t = 0; t < NQ; ++t) {
        float lr = l_run[t]; lr += __shfl_xor(lr, 16); lr += __shfl_xor(lr, 32);
        const float mr = m_run[t];
        LAS float* mrow = MBuf + (qpos[t] - p0) * AT_MB_PITCH;
        if (br == 0) {
#pragma unroll
            for (int dt = 0; dt < 4; ++dt) *(LAS f32x4*)(mrow + dt * 16 + 4 * fq) = o[t][dt];
            if (fq == 0) { mrow[64] = mr; mrow[65] = lr; }
        } else {
            const float m0 = mrow[64], l0 = mrow[65];
            const float mm = fmaxf(m0, mr); const float a0 = fexp2(m0 - mm), a1 = fexp2(mr - mm);
            const float ll = a0 * l0 + a1 * lr;
            f32x4 om[4];
#pragma unroll
            for (int dt = 0; dt < 4; ++dt) om[dt] = *(LAS f32x4*)(mrow + dt * 16 + 4 * fq) * a0 + o[t][dt] * a1;
            if (br == 1) {
#pragma unroll
                for (int dt = 0; dt < 4; ++dt) *(LAS f32x4*)(mrow + dt * 16 + 4 * fq) = om[dt];
                if (fq == 0) { mrow[64] = mm; mrow[65] = ll; }
            } else {
                const float inv = 1.0f / ll;
                bf16_t* op = MIX + (rowb + qpos[t]) * DM + h * 64 + 4 * fq;
#pragma unroll
                for (int dt = 0; dt < 4; ++dt) { u32x2 w; w.x = pk2(om[dt][0] * inv, om[dt][1] * inv); w.y = pk2(om[dt][2] * inv, om[dt][3] * inv); *(u32x2*)(op + dt * 16) = w; }
            }
        }
    }
}
__device__ __forceinline__ void attn_prompt_unit(LAS unsigned char* lds, const bf16_t* QB, const bf16_t* KB, const bf16_t* VB, bf16_t* MIX, int b, int h, int blk, int wave, int lane) {
    LAS float* MBuf = (LAS float*)lds;
    LAS unsigned char* vs = lds + AT_MB_BYTES + wave * AT_VS_BYTES;
    const int p0 = blk * 256;
    const float slope2 = fexp2(-(float)(h + 1)) * LOG2E;
    const size_t rowb = (size_t)b * SEQ;
    attn_tile<2>(MBuf, vs, QB, KB, VB, MIX, rowb, h, p0, 0, 0, p0 + 32 * wave, slope2, lane);
    __syncthreads();
    attn_tile<2>(MBuf, vs, QB, KB, VB, MIX, rowb, h, p0, 1, wave & 3, (p0 >> 2) + 32 * (wave >> 2), slope2, lane);
    __syncthreads();
#pragma unroll 1
    for (int tt2 = 0; tt2 < 2; ++tt2) attn_tile<1>(MBuf, vs, QB, KB, VB, MIX, rowb, h, p0, 2, 2 * wave + tt2, p0 >> 4, slope2, lane);
    __syncthreads();
}

__device__ __forceinline__ void attn_sample_unit(LAS unsigned char* lds, const bf16_t* QB, const float* cwk, const float* cwv, const float* out, bf16_t* MIX, int b, int h, int wave, int lane) {
    const int t = wave, sub = lane & 15, g = lane >> 4;
    const int row = NP + b * 8 + t;
    const float slope2 = fexp2(-(float)(h + 1)) * LOG2E;
    float q[4];
    { const u32x2 qw = *(const u32x2*)(QB + (size_t)row * 512 + h * 64 + 4 * sub); q[0] = bflo(qw.x); q[1] = bfhi(qw.x); q[2] = bflo(qw.y); q[3] = bfhi(qw.y); }
    float m = -INFINITY, l = 0.f; f32x4 acc = (f32x4){0.f, 0.f, 0.f, 0.f};
#pragma unroll 1
    for (int it0 = 0; it0 < 112; it0 += 16) {
        f32x4 k4[16], v4[16]; float s[16];
#pragma unroll
        for (int i = 0; i < 16; ++i) {
            const int idx = (it0 + i) * 4 + g; const int idc = idx > 386 ? 386 : idx;
            const int br = idc / 129, j = idc - br * 129; const int dist = j << (2 * br);
            const int uu = 2048 + t - dist;
            const size_t offn = (size_t)(b * 8 + (uu - 2048)) * 512 + h * 64 + 4 * sub, offc = ((size_t)(b * 2048 + uu) * 8 + h) * 64 + 4 * sub;
            k4[i] = *(const f32x4*)((uu >= 2048) ? out + O_WKS + offn : cwk + offc);
            v4[i] = *(const f32x4*)((uu >= 2048) ? out + O_WVS + offn : cwv + offc);
        }
        float bm = -INFINITY;
#pragma unroll
        for (int i = 0; i < 16; ++i) {
            const int idx = (it0 + i) * 4 + g; const int idc = idx > 386 ? 386 : idx;
            const int br = idc / 129, j = idc - br * 129; const int dist = j << (2 * br);
            float d = (q[0] * k4[i][0] + q[1] * k4[i][1]) + (q[2] * k4[i][2] + q[3] * k4[i][3]);
            d += __shfl_xor(d, 1); d += __shfl_xor(d, 2); d += __shfl_xor(d, 4); d += __shfl_xor(d, 8);
            d -= slope2 * (float)dist;
            s[i] = idx <= 386 ? d : -INFINITY; bm = fmaxf(bm, s[i]);
        }
        const float m_new = fmaxf(m, bm); const float mref = (m_new == -INFINITY) ? 0.f : m_new;
        const float alpha = fexp2(m - mref);
        l *= alpha; acc = acc * alpha; m = m_new;
#pragma unroll
        for (int i = 0; i < 16; ++i) { const float p = fexp2(s[i] - mref); l += p; acc = acc + v4[i] * p; }
    }
    float mall = fmaxf(m, __shfl_xor(m, 16)); mall = fmaxf(mall, __shfl_xor(mall, 32));
    const float sc = fexp2(m - mall);
    l *= sc; acc = acc * sc;
#pragma unroll
    for (int e = 0; e < 4; ++e) { acc[e] += __shfl_xor(acc[e], 16); acc[e] += __shfl_xor(acc[e], 32); }
    l += __shfl_xor(l, 16); l += __shfl_xor(l, 32);
    if (g == 0) { const float inv = 1.0f / l; u32x2 w; w.x = pk2(acc[0] * inv, acc[1] * inv); w.y = pk2(acc[2] * inv, acc[3] * inv);
        *(u32x2*)(MIX + (size_t)row * DM + h * 64 + 4 * sub) = w; }
}

constexpr int CV_TILE_BYTES = 94 * 1024;
__device__ __forceinline__ void conv_unit(LAS unsigned char* lds, int kind, int b, int p0, const bf16_t* UB, const float* cconv, const float* cw, const float* cb, const float* lng, const float* lnb,
                                          bf16_t* MIX, int tid, int wave, int lane) {
    LAS unsigned* T = (LAS unsigned*)lds;
    LAS float* ST = (LAS float*)(lds + CV_TILE_BYTES);
    if (kind == 0) {
        u32x4 w[12];
#pragma unroll
        for (int i = 0; i < 12; ++i) { const int id = tid + NTHREADS * i, rr = id >> 6, c8 = id & 63; const int pos = p0 - 30 + rr;
            w[i] = (u32x4){0u, 0u, 0u, 0u}; if (id < 94 * 64 && pos >= 0) w[i] = *(const u32x4*)(UB + ((size_t)b * SEQ + pos) * 512 + c8 * 8); }
#pragma unroll
        for (int i = 0; i < 12; ++i) { const int id = tid + NTHREADS * i, rr = id >> 6, c8 = id & 63; if (id < 94 * 64) *(LAS u32x4*)(lds + rr * 1024 + c8 * 16) = w[i]; }
    } else
    for (int id = tid; id < 94 * 64; id += NTHREADS) {
        const int rr = id >> 6, c8 = id & 63; u32x4 w = (u32x4){0u, 0u, 0u, 0u};
        if (rr < 30) { const f32x4* s = (const f32x4*)(cconv + ((size_t)b * 30 + rr) * 512 + c8 * 8); const f32x4 a = s[0], c = s[1];
            w.x = pk2(a[0], a[1]); w.y = pk2(a[2], a[3]); w.z = pk2(c[0], c[1]); w.w = pk2(c[2], c[3]); }
        else if (rr < 38) w = *(const u32x4*)(UB + ((size_t)NP + b * 8 + (rr - 30)) * 512 + c8 * 8);
        *(LAS u32x4*)(lds + rr * 1024 + c8 * 16) = w;
    }
    const int cp = tid & 255, half = tid >> 8, w4 = wave & 3;
    typedef __bf16 bf2_t __attribute__((ext_vector_type(2)));
    unsigned w0[31], w1[31];
#pragma unroll
    for (int j = 0; j < 31; ++j) { const f32x2 ww = *(const f32x2*)(cw + j * 512 + 2 * cp); w0[j] = pk2(ww[0], 0.f); w1[j] = pk2(0.f, ww[1]); }
    const f32x2 cbv = *(const f32x2*)(cb + 2 * cp), gv = *(const f32x2*)(lng + 2 * cp), bv = *(const f32x2*)(lnb + 2 * cp);
    __syncthreads();
    const int nchunks = kind == 0 ? 4 : 1;
    const size_t orow0 = kind == 0 ? (size_t)b * SEQ + p0 : (size_t)NP + b * 8;
#pragma unroll 1
    for (int ch = 0; ch < nchunks; ++ch) {
        float a0[8], a1[8];
#pragma unroll
        for (int pp = 0; pp < 8; ++pp) {
            const int pl = half * 32 + ch * 8 + pp;
            float c0 = cbv[0], c1 = cbv[1];
#pragma unroll
            for (int j = 0; j < 31; ++j) { const unsigned uu = T[(pl + j) * 256 + cp];
                c0 = __builtin_amdgcn_fdot2_f32_bf16(__builtin_bit_cast(bf2_t, uu), __builtin_bit_cast(bf2_t, w0[j]), c0, false);
                c1 = __builtin_amdgcn_fdot2_f32_bf16(__builtin_bit_cast(bf2_t, uu), __builtin_bit_cast(bf2_t, w1[j]), c1, false); }
            a0[pp] = c0; a1[pp] = c1;
            asm volatile("" ::: "memory");
        }
        {
            float r[16];
#pragma unroll
            for (int pp = 0; pp < 8; ++pp) { r[2 * pp] = a0[pp] + a1[pp]; r[2 * pp + 1] = a0[pp] * a0[pp] + a1[pp] * a1[pp]; }
            { const bool bt = (lane & 32) != 0;
#pragma unroll
              for (int i = 0; i < 8; ++i) { const float snd = bt ? r[i] : r[i + 8], kp = bt ? r[i + 8] : r[i]; r[i] = kp + __shfl_xor(snd, 32); } }
            { const bool bt = (lane & 16) != 0;
#pragma unroll
              for (int i = 0; i < 4; ++i) { const float snd = bt ? r[i] : r[i + 4], kp = bt ? r[i + 4] : r[i]; r[i] = kp + __shfl_xor(snd, 16); } }
            { const bool bt = (lane & 8) != 0;
#pragma unroll
              for (int i = 0; i < 2; ++i) { const float snd = bt ? r[i] : r[i + 2], kp = bt ? r[i + 2] : r[i]; r[i] = kp + __shfl_xor(snd, 8); } }
            { const bool bt = (lane & 4) != 0; const float snd = bt ? r[0] : r[1], kp = bt ? r[1] : r[0]; r[0] = kp + __shfl_xor(snd, 4); }
            r[0] += __shfl_xor(r[0], 2); r[0] += __shfl_xor(r[0], 1);
            if ((lane & 3) == 0) { const int v = ((lane >> 5) & 1) * 8 + ((lane >> 4) & 1) * 4 + ((lane >> 3) & 1) * 2 + ((lane >> 2) & 1);
                ST[((half * 8 + (v >> 1)) * 4 + w4) * 2 + (v & 1)] = r[0]; }
        }
        __syncthreads();
        const bool valid = kind == 0 || half == 0;
#pragma unroll
        for (int pp = 0; pp < 8; ++pp) {
            const LAS float* sp = ST + (half * 8 + pp) * 8;
            const float S1 = (sp[0] + sp[2]) + (sp[4] + sp[6]), S2 = (sp[1] + sp[3]) + (sp[5] + sp[7]);
            const float mean = S1 * (1.0f / 512.0f); const float var = S2 * (1.0f / 512.0f) - mean * mean;
            const float rstd = __builtin_amdgcn_rsqf(fmaxf(var, 0.f) + EPS);
            const float y0 = (a0[pp] - mean) * rstd * gv[0] + bv[0], y1 = (a1[pp] - mean) * rstd * gv[1] + bv[1];
            if (valid) *(unsigned*)(MIX + (orow0 + half * 32 + ch * 8 + pp) * DM + 512 + 2 * cp) = pk2(silu_f(y0), silu_f(y1));
        }
        __syncthreads();
    }
}

constexpr int XA_KP = 528, XA_VP = 544;
__device__ __forceinline__ void xattn_unit(LAS unsigned char* lds, const void* Kp, const void* Vp, bool kvf32, int pitch, const bf16_t* QX, bf16_t* OX, int qrow0, int nq, int h, int tid, int wave, int lane) {
    const int fr = lane & 15, fq = lane >> 4;
    if (!kvf32) {
        u32x4 w[16];
#pragma unroll
        for (int i = 0; i < 16; ++i) { const int id = tid + NTHREADS * i, rr = id >> 5, c = id & 31; w[i] = *(const u32x4*)((const bf16_t*)Kp + (size_t)rr * pitch + c * 8); }
#pragma unroll
        for (int i = 0; i < 16; ++i) { const int id = tid + NTHREADS * i, rr = id >> 5, c = id & 31; *(LAS u32x4*)(lds + rr * XA_KP + c * 16) = w[i]; }
    } else {
#pragma unroll 1
        for (int i0 = 0; i0 < 16; i0 += 8) {
            f32x4 fa[8], fd[8];
#pragma unroll
            for (int i = 0; i < 8; ++i) { const int id = tid + NTHREADS * (i0 + i), rr = id >> 5, c = id & 31; const f32x4* sp = (const f32x4*)((const float*)Kp + (size_t)rr * pitch + c * 8); fa[i] = sp[0]; fd[i] = sp[1]; }
#pragma unroll
            for (int i = 0; i < 8; ++i) { const int id = tid + NTHREADS * (i0 + i), rr = id >> 5, c = id & 31; u32x4 w; w.x = pk2(fa[i][0], fa[i][1]); w.y = pk2(fa[i][2], fa[i][3]); w.z = pk2(fd[i][0], fd[i][1]); w.w = pk2(fd[i][2], fd[i][3]);
                *(LAS u32x4*)(lds + rr * XA_KP + c * 16) = w; }
        }
    }
    __syncthreads();
    const bool active = 16 * wave < nq;
    int qr = qrow0 + 16 * wave + fr; if (qr > qrow0 + nq - 1) qr = qrow0 + nq - 1;
    bf16x8 pf[8]; float linv = 0.f;
    if (active) {
        bf16x8 qf[8];
        const bf16_t* qp = QX + (size_t)qr * DM + h * 256 + fq * 8;
#pragma unroll
        for (int ks = 0; ks < 8; ++ks) qf[ks] = *(const bf16x8*)(qp + ks * 32);
        f32x4 s[16]; float mx = -INFINITY;
#pragma unroll
        for (int c = 0; c < 16; ++c) {
            f32x4 a = (f32x4){0.f, 0.f, 0.f, 0.f};
            const LAS unsigned char* kr = lds + (16 * c + fr) * XA_KP + fq * 16;
#pragma unroll
            for (int ks = 0; ks < 8; ++ks) a = __builtin_amdgcn_mfma_f32_16x16x32_bf16(*(const LAS bf16x8*)(kr + ks * 64), qf[ks], a, 0, 0, 0);
            s[c] = a; mx = fmaxf(fmaxf(mx, fmaxf(a[0], a[1])), fmaxf(a[2], a[3]));
        }
        mx = fmaxf(mx, __shfl_xor(mx, 16)); mx = fmaxf(mx, __shfl_xor(mx, 32));
        float l = 0.f;
#pragma unroll
        for (int c = 0; c < 16; ++c) {
#pragma unroll
            for (int e = 0; e < 4; ++e) { s[c][e] = fexp2(s[c][e] - mx); l += s[c][e]; }
        }
        l += __shfl_xor(l, 16); l += __shfl_xor(l, 32); linv = 1.0f / l;
#pragma unroll
        for (int k2 = 0; k2 < 8; ++k2) { u32x4 pw; pw.x = pk2(s[2 * k2][0], s[2 * k2][1]); pw.y = pk2(s[2 * k2][2], s[2 * k2][3]); pw.z = pk2(s[2 * k2 + 1][0], s[2 * k2 + 1][1]); pw.w = pk2(s[2 * k2 + 1][2], s[2 * k2 + 1][3]);
            pf[k2] = __builtin_bit_cast(bf16x8, pw); }
    }
    __syncthreads();
    if (!kvf32) {
        u32x4 w[16];
#pragma unroll
        for (int i = 0; i < 16; ++i) { const int id = tid + NTHREADS * i, rr = id >> 5, c = id & 31; w[i] = *(const u32x4*)((const bf16_t*)Vp + (size_t)rr * pitch + c * 8); }
#pragma unroll
        for (int i = 0; i < 16; ++i) { const int id = tid + NTHREADS * i, rr = id >> 5, c = id & 31; *(LAS u32x4*)(lds + rr * XA_VP + c * 16) = w[i]; }
    } else {
#pragma unroll 1
        for (int i0 = 0; i0 < 16; i0 += 8) {
            f32x4 fa[8], fd[8];
#pragma unroll
            for (int i = 0; i < 8; ++i) { const int id = tid + NTHREADS * (i0 + i), rr = id >> 5, c = id & 31; const f32x4* sp = (const f32x4*)((const float*)Vp + (size_t)rr * pitch + c * 8); fa[i] = sp[0]; fd[i] = sp[1]; }
#pragma unroll
            for (int i = 0; i < 8; ++i) { const int id = tid + NTHREADS * (i0 + i), rr = id >> 5, c = id & 31; u32x4 w; w.x = pk2(fa[i][0], fa[i][1]); w.y = pk2(fa[i][2], fa[i][3]); w.z = pk2(fd[i][0], fd[i][1]); w.w = pk2(fd[i][2], fd[i][3]);
                *(LAS u32x4*)(lds + rr * XA_VP + c * 16) = w; }
        }
    }
    __syncthreads();
    if (active) {
        const int tq = fr >> 2, tp = fr & 3;
        const LAS unsigned char* tb = lds + (4 * fq + tq) * XA_VP + tp * 8;
        const bool wr_ok = 16 * wave + fr < nq;
        bf16_t* op = OX + (size_t)qr * DM + h * 256 + 4 * fq;
#pragma unroll 4
        for (int dt = 0; dt < 16; ++dt) {
            f32x4 o = (f32x4){0.f, 0.f, 0.f, 0.f};
#pragma unroll
            for (int k2 = 0; k2 < 8; ++k2) {
                const s16x4 a = lds_tr(tb + (32 * k2) * XA_VP + dt * 32), bb = lds_tr(tb + (32 * k2 + 16) * XA_VP + dt * 32);
                const bf16x8 vf = (bf16x8){a[0], a[1], a[2], a[3], bb[0], bb[1], bb[2], bb[3]};
                o = __builtin_amdgcn_mfma_f32_16x16x32_bf16(vf, pf[k2], o, 0, 0, 0);
            }
            if (wr_ok) { u32x2 w; w.x = pk2(o[0] * linv, o[1] * linv); w.y = pk2(o[2] * linv, o[3] * linv); *(u32x2*)(op + dt * 16) = w; }
        }
    }
    __syncthreads();
}


constexpr int SG_PITCH = 528;
constexpr int SG_WAVE_BYTES = 32 * SG_PITCH;
template <int NT, int UNR> __device__ __forceinline__ void sgemm(LAS unsigned char* lds, const bf16_t* A, const bf16_t* Bt, int K, const int (&brow)[NT], int wave, int lane, f32x4 (&acc)[2][NT]) {
    static_assert(UNR == 8, "one staged block = 8 k-steps");
    const int fr = lane & 15, fq = lane >> 4;
    LAS unsigned char* st = lds + wave * SG_WAVE_BYTES;
    const bf16_t* ar = A + (size_t)(32 * wave + (lane >> 3)) * K + (lane & 7) * 8;
    LAS unsigned char* wr = st + (lane >> 3) * SG_PITCH + (lane & 7) * 16;
    const LAS unsigned char* rd = st + fr * SG_PITCH + fq * 16;
    const bf16_t* bp[NT];
#pragma unroll
    for (int nt = 0; nt < NT; ++nt) { bp[nt] = Bt + (size_t)brow[nt] * K + fq * 8; acc[0][nt] = (f32x4){0.f, 0.f, 0.f, 0.f}; acc[1][nt] = (f32x4){0.f, 0.f, 0.f, 0.f}; }
    const int nks = K / 32;
#pragma unroll 1
    for (int k0 = 0; k0 < nks; k0 += 8) {
        bf16x8 al[4][4], bf[8][NT];
#pragma unroll
        for (int rg = 0; rg < 4; ++rg)
#pragma unroll
            for (int ln = 0; ln < 4; ++ln) al[rg][ln] = *(const bf16x8*)(ar + (size_t)(8 * rg) * K + k0 * 32 + ln * 64);
#pragma unroll
        for (int u = 0; u < 8; ++u)
#pragma unroll
            for (int nt = 0; nt < NT; ++nt) bf[u][nt] = *(const bf16x8*)(bp[nt] + (k0 + u) * 32);
#pragma unroll
        for (int rg = 0; rg < 4; ++rg)
#pragma unroll
            for (int ln = 0; ln < 4; ++ln) *(LAS bf16x8*)(wr + (8 * rg) * SG_PITCH + ln * 128) = al[rg][ln];
#pragma unroll
        for (int u = 0; u < 8; ++u) {
            const bf16x8 af0 = *(const LAS bf16x8*)(rd + u * 64), af1 = *(const LAS bf16x8*)(rd + 16 * SG_PITCH + u * 64);
#pragma unroll
            for (int nt = 0; nt < NT; ++nt) {
                acc[0][nt] = __builtin_amdgcn_mfma_f32_16x16x32_bf16(bf[u][nt], af0, acc[0][nt], 0, 0, 0); acc[1][nt] = __builtin_amdgcn_mfma_f32_16x16x32_bf16(bf[u][nt], af1, acc[1][nt], 0, 0, 0); }
        }
    }
}
template <int NT> __device__ __forceinline__ void sgemm1(LAS unsigned char* lds, const bf16_t* A, const bf16_t* Bt, int K, const int (&brow)[NT], int row0, int wave, int lane, f32x4 (&acc)[NT]) {
    const int fr = lane & 15, fq = lane >> 4;
    LAS unsigned char* st = lds + wave * SG_WAVE_BYTES;
    const bf16_t* ar = A + (size_t)(row0 + 16 * wave + (lane >> 3)) * K + (lane & 7) * 8;
    LAS unsigned char* wr = st + (lane >> 3) * SG_PITCH + (lane & 7) * 16;
    const LAS unsigned char* rd = st + fr * SG_PITCH + fq * 16;
    const bf16_t* bp[NT];
#pragma unroll
    for (int nt = 0; nt < NT; ++nt) { bp[nt] = Bt + (size_t)brow[nt] * K + fq * 8; acc[nt] = (f32x4){0.f, 0.f, 0.f, 0.f}; }
    const int nks = K / 32;
    bf16x8 al[2][4], bf[8][NT];
#define SG1_LOAD(AL, BF, K0) do { _Pragma("unroll") for (int rg_ = 0; rg_ < 2; ++rg_) _Pragma("unroll") for (int ln_ = 0; ln_ < 4; ++ln_) AL[rg_][ln_] = *(const bf16x8*)(ar + (size_t)(8 * rg_) * K + (K0) * 32 + ln_ * 64); \
        _Pragma("unroll") for (int u_ = 0; u_ < 8; ++u_) _Pragma("unroll") for (int nt_ = 0; nt_ < NT; ++nt_) BF[u_][nt_] = *(const bf16x8*)(bp[nt_] + ((K0) + u_) * 32); } while (0)
    SG1_LOAD(al, bf, 0);
#pragma unroll 1
    for (int k0 = 0; k0 < nks; k0 += 8) {
        bf16x8 nal[2][4], nbf[8][NT];
        { const int kn = k0 + 8 < nks ? k0 + 8 : k0; SG1_LOAD(nal, nbf, kn); }
#pragma unroll
        for (int rg = 0; rg < 2; ++rg)
#pragma unroll
            for (int ln = 0; ln < 4; ++ln) *(LAS bf16x8*)(wr + (8 * rg) * SG_PITCH + ln * 128) = al[rg][ln];
#pragma unroll
        for (int u = 0; u < 8; ++u) {
            const bf16x8 af0 = *(const LAS bf16x8*)(rd + u * 64);
#pragma unroll
            for (int nt = 0; nt < NT; ++nt) acc[nt] = __builtin_amdgcn_mfma_f32_16x16x32_bf16(bf[u][nt], af0, acc[nt], 0, 0, 0);
        }
#pragma unroll
        for (int rg = 0; rg < 2; ++rg)
#pragma unroll
            for (int ln = 0; ln < 4; ++ln) al[rg][ln] = nal[rg][ln];
#pragma unroll
        for (int u = 0; u < 8; ++u)
#pragma unroll
            for (int nt = 0; nt < NT; ++nt) bf[u][nt] = nbf[u][nt];
    }
#undef SG1_LOAD
}
template <bool PART> __device__ __forceinline__ void s_gu(LAS unsigned char* lds, const bf16_t* XBs, const bf16_t* Wgu, bf16_t* ACT, const float* ssq, int s, int wave, int lane) {
    const int fr = lane & 15, fq = lane >> 4;
    int j = 11 * s + fr; j = j > FF - 1 ? FF - 1 : j;
    int brow[2]; brow[0] = (j >> 7) * 256 + (j & 127); brow[1] = brow[0] + 128;
    f32x4 acc[2][2]; sgemm<2, 8>(lds, XBs, Wgu, DM, brow, wave, lane, acc);
#pragma unroll
    for (int mt = 0; mt < 2; ++mt) { const int r = NP + 32 * wave + 16 * mt + fr; const float rs = rstd_of(PART ? samp_ss(ssq, r - NP, fq) : ssq[r]);
#pragma unroll
        for (int e = 0; e < 4; ++e) if (4 * fq + e < 11) { const float g = acc[mt][0][e] * rs, up = acc[mt][1][e] * rs;
            ACT[(size_t)r * FF + 11 * s + 4 * fq + e] = (bf16_t)(pk2(silu_f(g) * up, 0.f) & 0xffffu); } }
}
template <bool BASE_F32, bool OUT_F32> __device__ __forceinline__ void s_res(LAS unsigned char* lds, const bf16_t* As, int K, const bf16_t* Wt, const float* base_s, float* X, bf16_t* XB, float* ssq, float scale, int s, int wave, int lane) {
    const int fr = lane & 15, fq = lane >> 4;
    const int rg = s & 1, cg = s >> 1;
    int brow[1]; brow[0] = 8 * cg + (fr < 7 ? fr : 7);
    f32x4 acc[1]; sgemm1<1>(lds, As, Wt, K, brow, 128 * rg, wave, lane, acc);
    const int rr = 128 * rg + 16 * wave + fr, r = NP + rr; const int col = 8 * cg + 4 * (fq & 1);
    float sq = 0.f;
    if (fq < 2) {
        f32x4 b;
        if (BASE_F32) b = *(const f32x4*)(base_s + (size_t)rr * DM + col);
        else { const u32x2 w = *(const u32x2*)(XB + (size_t)r * DM + col); b = (f32x4){bflo(w.x), bfhi(w.x), bflo(w.y), bfhi(w.y)}; }
        const f32x4 v = b + acc[0] * scale;
        if (OUT_F32) *(f32x4*)(X + (size_t)r * DM + col) = v;
        else { u32x2 w; w.x = pk2(v[0], v[1]); w.y = pk2(v[2], v[3]); *(u32x2*)(XB + (size_t)r * DM + col) = w; }
        sq = (v[0] * v[0] + v[1] * v[1]) + (v[2] * v[2] + v[3] * v[3]);
    }
    sq += __shfl_xor(sq, 16);
    if (fq == 0) ssq[(size_t)rr * 128 + cg] = sq;
}
__device__ __forceinline__ void s_cq(LAS unsigned char* lds, const bf16_t* XBs, const bf16_t* Wt, bf16_t* QX, const float* ssq, float scale, int s, int wave, int lane) {
    const int fr = lane & 15, fq = lane >> 4;
    const int rg = s & 1, cg = s >> 1;
    int brow[1]; brow[0] = 8 * cg + (fr < 7 ? fr : 7);
    f32x4 acc[1]; sgemm1<1>(lds, XBs, Wt, DM, brow, 128 * rg, wave, lane, acc);
    const int rr = 128 * rg + 16 * wave + fr, r = NP + rr;
    const float rs = rstd_of(samp_ss(ssq, rr, fq)) * scale;
    if (fq < 2) { const f32x4 v = acc[0] * rs; u32x2 w; w.x = pk2(v[0], v[1]); w.y = pk2(v[2], v[3]); *(u32x2*)(QX + (size_t)r * DM + 8 * cg + 4 * fq) = w; }
}
__device__ __forceinline__ void s_win(LAS unsigned char* lds, const bf16_t* XBs, const bf16_t* Win, bf16_t* QB, bf16_t* KB, bf16_t* VB, bf16_t* UB, float* out, const float* ssq, int s, int wave, int lane) {
    const int fr = lane & 15, fq = lane >> 4;
    int brow[3]; brow[0] = 6 * s + (fr < 5 ? fr : 5);
    { const int c = 2 * s + (fr < 1 ? fr : 1); brow[1] = 1536 + (c >> 7) * 256 + (c & 127); brow[2] = brow[1] + 128; }
    f32x4 acc[2][3]; sgemm<3, 8>(lds, XBs, Win, DM, brow, wave, lane, acc);
#pragma unroll
    for (int mt = 0; mt < 2; ++mt) { const int r = NP + 32 * wave + 16 * mt + fr; const int rr = r - NP; const float rs = rstd_of(samp_ss(ssq, rr, fq));
#pragma unroll
        for (int e = 0; e < 4; ++e) if (4 * fq + e < 6) { const int col = 6 * s + 4 * fq + e, sec = col >> 9, cc = col & 511; const float v = acc[mt][0][e] * rs;
            if (sec == 0) QB[(size_t)r * 512 + cc] = (bf16_t)(pk2(v * (0.125f * LOG2E), 0.f) & 0xffffu);
            else if (sec == 1) { out[O_WKS + (size_t)rr * 512 + cc] = v; KB[(size_t)r * 512 + cc] = (bf16_t)(pk2(v, 0.f) & 0xffffu); }
            else { out[O_WVS + (size_t)rr * 512 + cc] = v; VB[(size_t)r * 512 + cc] = (bf16_t)(pk2(v, 0.f) & 0xffffu); } }
        if (fq == 0) {
#pragma unroll
            for (int e = 0; e < 2; ++e) { const int c = 2 * s + e; const float uu = acc[mt][1][e] * rs * sigm_f(acc[mt][2][e] * rs);
                UB[(size_t)r * 512 + c] = (bf16_t)(pk2(uu, 0.f) & 0xffffu); out[O_CS + ((size_t)(rr >> 3) * 30 + 22 + (rr & 7)) * 512 + c] = uu; } }
    }
}

#define XB_TMO      128
#define XB_XCNT(j)  (256  + 64 * (j))
#define XB_XSUB(j)  (1280 + 64 * (j))
#define XB_XGEN(j)  (2304 + 64 * (j))
#define XB_TOP      3328
#define XB_TOPGEN   3392
#define XCD_BAR_WORDS 3456
#define XB_SPIN_CAP (1u << 18)

__device__ __forceinline__ unsigned xb_ld(unsigned* p)              { return __hip_atomic_load(p, __ATOMIC_RELAXED, __HIP_MEMORY_SCOPE_AGENT); }
__device__ __forceinline__ unsigned xb_add(unsigned* p, unsigned v) { return __hip_atomic_fetch_add(p, v, __ATOMIC_RELAXED, __HIP_MEMORY_SCOPE_AGENT); }
__device__ __forceinline__ unsigned xb_xcc_id() { return (unsigned)__builtin_amdgcn_s_getreg((3 << 11) | 20) & 0xFu; }
#define XB_SPIN(cond, bar) do { unsigned _sp = 0; while (cond) { __builtin_amdgcn_s_sleep(1); \
    if ((++_sp & 255u) == 0u) { if (xb_ld(&(bar)[XB_TMO])) break; if (_sp > XB_SPIN_CAP) { atomicAdd(&(bar)[XB_TMO], 1u); break; } } } } while (0)

struct XcdBarrier {
    unsigned* bar; unsigned x;
    volatile LAS unsigned* st;
};

__device__ __forceinline__ XcdBarrier xcd_barrier_post(unsigned* bar, volatile LAS unsigned* st) {
    XcdBarrier b; b.bar = bar; b.x = xb_xcc_id(); b.st = st;
    if (threadIdx.x == 0) (void)xb_add(&bar[XB_XCNT(b.x)], 1u);
    return b;
}
__device__ __forceinline__ void xcd_barrier_complete(unsigned* bar, unsigned x, unsigned& nloc, unsigned& nx) {
    const unsigned G = gridDim.x * gridDim.y * gridDim.z;
    unsigned sum, cnt, mine, sp = 0u;
    for (;;) {
        sum = 0u; cnt = 0u; mine = 0u;
#pragma unroll
        for (unsigned j = 0; j < 16; ++j) { const unsigned c = xb_ld(&bar[XB_XCNT(j)]); sum += c; cnt += (c > 0u) ? 1u : 0u; mine = (j == x) ? c : mine; }
        if (sum == G) break;
        __builtin_amdgcn_s_sleep(1);
        if ((++sp & 255u) == 0u) { if (xb_ld(&bar[XB_TMO])) break; if (sp > XB_SPIN_CAP) { atomicAdd(&bar[XB_TMO], 1u); break; } }
    }
    nloc = mine > 0u ? mine : 1u; nx = cnt > 0u ? cnt : 1u;
}

__device__ __forceinline__ void xcd_barrier(const XcdBarrier& b) {
    asm volatile("s_waitcnt vmcnt(0)" ::: "memory");
    __syncthreads();
    if (threadIdx.x == 0) {
        unsigned* bar = b.bar;
        __builtin_amdgcn_s_waitcnt(0);
        unsigned nloc = b.st[0], nx = b.st[1];
        if (nloc == 0u) { xcd_barrier_complete(bar, b.x, nloc, nx); b.st[0] = nloc; b.st[1] = nx; }
        const unsigned old = xb_add(&bar[XB_XSUB(b.x)], 1u);
        const unsigned gen = old / nloc;
        if (old + 1u == (gen + 1u) * nloc) {
            __builtin_amdgcn_fence(__ATOMIC_RELEASE, "agent");
            asm volatile("s_waitcnt vmcnt(0)" ::: "memory");
            const unsigned og = xb_add(&bar[XB_TOP], 1u);
            const unsigned tg = og / nx;
            if (og + 1u == (tg + 1u) * nx) xb_add(&bar[XB_TOPGEN], 1u);
            else XB_SPIN(xb_ld(&bar[XB_TOPGEN]) == tg, bar);
            __builtin_amdgcn_fence(__ATOMIC_ACQUIRE, "agent");
            xb_add(&bar[XB_XGEN(b.x)], 1u);
            asm volatile("s_waitcnt vmcnt(0)" ::: "memory");
        } else {
            XB_SPIN(xb_ld(&bar[XB_XGEN(b.x)]) == gen, bar);
            __builtin_amdgcn_fence(__ATOMIC_ACQUIRE, "agent");
            asm volatile("s_waitcnt vmcnt(0)" ::: "memory");
        }
    }
    __syncthreads();
}

#define GEMM_PHASE(EPI, A_, B_, M_, N_, K_, E_) do { pg8::Gemm g_{(const bf16_t*)(A_), (const bf16_t*)(B_), (M_), (N_), (K_)}; pg8::StaticOrder S_; S_.init((M_), (N_), G, (int)blockIdx.x); \
        pg8::gemm_phase<EPI, pg8::StaticOrder, true, true>(lds, g_, S_, (E_)); } while (0)

#ifndef REP_P0
#define REP_P0 1
#endif
#define STAGGER2(GEMM_STMT, SLICE_STMT) do { if (bx & 1) { for (int sl = bx; sl < 256; sl += G) { SLICE_STMT; } __syncthreads();   } GEMM_STMT; if (!(bx & 1)) { for (int sl = bx; sl < 256; sl += G) { SLICE_STMT; } } } while (0)
__global__ void __launch_bounds__(NTHREADS, 2) fwd_megakernel(Args args) {
    extern __shared__ __attribute__((aligned(16))) unsigned char lds_raw[];
    LAS unsigned char* lds = (LAS unsigned char*)lds_raw;
    const int tid = threadIdx.x, lane = tid & 63, wave = __builtin_amdgcn_readfirstlane(tid >> 6);
    const int G = gridDim.x, bx = blockIdx.x;
    unsigned char* ws = args.ws; float* out = args.out;
    float* ssq0 = (float*)(ws + WS_SSQ0); float* ssqm = (float*)(ws + WS_SSQM); float* ssqp = (float*)(ws + WS_SSQP); float* ssqs = (float*)(ws + WS_SSQS);
#define SSQP(k) (ssqp + (size_t)(k) * NP * 16)
#define SSQS(k) (ssqs + (size_t)(k) * 256 * 128)

    bf16_t* XB = (bf16_t*)(ws + WS_XB); bf16_t* MEMB = (bf16_t*)(ws + WS_MEMB); bf16_t* MKB = (bf16_t*)(ws + WS_MKB); bf16_t* MVB = (bf16_t*)(ws + WS_MVB);
    bf16_t* QB = (bf16_t*)(ws + WS_QB); bf16_t* KB = (bf16_t*)(ws + WS_KB); bf16_t* VB = (bf16_t*)(ws + WS_VB); bf16_t* UB = (bf16_t*)(ws + WS_UB);
    bf16_t* MIX = (bf16_t*)(ws + WS_MIX); bf16_t* QX = (bf16_t*)(ws + WS_QX); bf16_t* OX = (bf16_t*)(ws + WS_OX); bf16_t* ACT = (bf16_t*)(ws + WS_ACT);
    bf16_t* Wgu1 = (bf16_t*)(ws + WS_WGU1); bf16_t* Wd1 = (bf16_t*)(ws + WS_WD1); bf16_t* Win = (bf16_t*)(ws + WS_WIN); bf16_t* Wout = (bf16_t*)(ws + WS_WOUT);
    bf16_t* Wcq = (bf16_t*)(ws + WS_WCQ); bf16_t* Wckv = (bf16_t*)(ws + WS_WCKV); bf16_t* Wco = (bf16_t*)(ws + WS_WCO); bf16_t* Wgu2 = (bf16_t*)(ws + WS_WGU2); bf16_t* Wd2 = (bf16_t*)(ws + WS_WD2);
    const float* x_prompt = args.in[0]; const float* x_sample = args.in[1];
    float* X = out + O_Y;
    const int lo = args.ph_lo, hi = args.ph_hi;
    if (tid < 4) ((volatile LAS unsigned*)(lds + LDS_BYTES - 16))[tid] = 0u;
    __syncthreads();
    XcdBarrier xbar = xcd_barrier_post((unsigned*)(ws + WS_BAR), (volatile LAS unsigned*)(lds + LDS_BYTES - 16));
#ifndef SKIPMASK
#define SKIPMASK 0
#endif
#define IN(k) (!((SKIPMASK >> (k)) & 1) && lo <= (k) && (k) < hi)
#define SEAM(k) do { if (IN(k) && IN((k) + 1)) xcd_barrier(xbar); } while (0)

    if (IN(0)) {
        LAS float* scr = (LAS float*)(lds + wave * 16384);
        const int gw = bx * NWAVES + wave, NGW = G * NWAVES;
        constexpr int I_G = 16 * 88, I_D = 44 * 32, I_IN = 16 * 80, I_SQ = 16 * 32;
        constexpr int NITEMS = 6 * I_G + I_IN + 5 * I_SQ;
        for (int it = gw; it < NITEMS; it += NGW) {
            int r = it;
            if (r < I_G) { p0_transpose_item(args.in[9], DM, FF, Wgu1, 1, 0, args.in[8], scr, r, lane); continue; } r -= I_G;
            if (r < I_G) { p0_transpose_item(args.in[10], DM, FF, Wgu1, 2, 0, args.in[8], scr, r, lane); continue; } r -= I_G;
            if (r < I_D) { p0_transpose_item(args.in[11], FF, DM, Wd1, 0, 0, nullptr, scr, r, lane); continue; } r -= I_D;
            if (r < I_G) { p0_transpose_item(args.in[26], DM, FF, Wgu2, 1, 0, args.in[25], scr, r, lane); continue; } r -= I_G;
            if (r < I_G) { p0_transpose_item(args.in[27], DM, FF, Wgu2, 2, 0, args.in[25], scr, r, lane); continue; } r -= I_G;
            if (r < I_D) { p0_transpose_item(args.in[28], FF, DM, Wd2, 0, 0, nullptr, scr, r, lane); continue; } r -= I_D;
            if (r < I_IN) { p0_transpose_item(args.in[13], DM, 2560, Win, 3, 0, args.in[12], scr, r, lane); continue; } r -= I_IN;
            if (r < I_SQ) { p0_transpose_item(args.in[18], DM, DM, Wout, 0, 0, nullptr, scr, r, lane); continue; } r -= I_SQ;
            if (r < I_SQ) { p0_transpose_item(args.in[21], DM, DM, Wcq, 0, 0, args.in[19], scr, r, lane); continue; } r -= I_SQ;
            if (r < I_SQ) { p0_transpose_item(args.in[22], DM, DM, Wckv, 0, 0, args.in[20], scr, r, lane); continue; } r -= I_SQ;
            if (r < I_SQ) { p0_transpose_item(args.in[23], DM, DM, Wckv, 0, 1024, args.in[20], scr, r, lane); continue; } r -= I_SQ;
            p0_transpose_item(args.in[24], DM, DM, Wco, 0, 0, nullptr, scr, r, lane);
        }
        for (int m = gw; m < MT; m += 2 * NGW) {
            const int m1 = (m + NGW < MT) ? m + NGW : m;
            row2_to_bf16(m < NP ? x_prompt + (size_t)m * DM : x_sample + (size_t)(m - NP) * DM, m1 < NP ? x_prompt + (size_t)m1 * DM : x_sample + (size_t)(m1 - NP) * DM,
                         XB + (size_t)m * DM, XB + (size_t)m1 * DM, ssq0 + m, ssq0 + m1, lane);
        }
        for (int m = gw; m < NMEMROWS; m += NGW) row_to_bf16(args.in[2] + (size_t)m * DM, MEMB + (size_t)m * DM, ssqm + m, lane);
        for (int i = bx * NTHREADS + tid; i < 32 * 22 * 128; i += G * NTHREADS) { const int b = i / (22 * 128), rem = i - b * (22 * 128);
            *(f32x4*)(out + O_CS + (size_t)b * 30 * 512 + rem * 4) = *(const f32x4*)(args.in[5] + (size_t)b * 30 * 512 + 8 * 512 + rem * 4); }
    }
    SEAM(0);
    if (IN(1)) {
        { EpiGU<false> E{ACT, ssq0}; STAGGER2(GEMM_PHASE(EpiGU<false>, XB, Wgu1, NP, 2 * FF, DM, E), s_gu<false>(lds, XB + (size_t)NP * DM, Wgu1, ACT, ssq0, sl, wave, lane)); }
        __syncthreads();
        { EpiMemKV E{MKB, MVB, out, ssqm}; GEMM_PHASE(EpiMemKV, MEMB, Wckv, NMEMROWS, 2048, DM, E); }
    }
    SEAM(1);
    if (IN(2)) { typedef EpiRes<true, false> ER; ER E{x_prompt, X, XB, SSQP(0), 0.5f};
        STAGGER2(GEMM_PHASE(ER, ACT, Wd1, NP, DM, FF, E), (s_res<true, false>(lds, ACT + (size_t)NP * FF, FF, Wd1, x_sample, X, XB, SSQS(0), 0.5f, sl, wave, lane))); }
    SEAM(2);
    if (IN(3)) { EpiWin E{QB, KB, VB, UB, out, SSQP(0)}; STAGGER2(GEMM_PHASE(EpiWin, XB, Win, NP, 2560, DM, E), s_win(lds, XB + (size_t)NP * DM, Win, QB, KB, VB, UB, out, SSQS(0), sl, wave, lane)); }
    SEAM(3);
    if (IN(4)) {
#ifndef REP_AP
#define REP_AP 1
#endif
#ifndef REP_AS
#define REP_AS 1
#endif
#ifndef REP_CV
#define REP_CV 1
#endif
#ifndef REP_XA
#define REP_XA 1
#endif
#ifndef REP_P0
#define REP_P0 1
#endif
#ifndef NO_ATTNP
        for (int rep = 0; rep < REP_AP; ++rep)
        for (int u = bx; u < 1024; u += G) {
            const int xcd = u & 7, j = u >> 3; const int b = xcd * 2 + (j >> 6), jj = j & 63, h = jj & 7, blk = jj >> 3;
            attn_prompt_unit(lds, QB, KB, VB, MIX, b, h, blk, wave, lane);
        }
#endif
#ifndef NO_ATTNS
        for (int rep = 0; rep < REP_AS; ++rep)
        for (int u = bx; u < 256; u += G) attn_sample_unit(lds, QB, args.in[3], args.in[4], out, MIX, u >> 3, u & 7, wave, lane);
#endif
        __syncthreads();
#ifndef NO_CONV
        for (int rep = 0; rep < REP_CV; ++rep)
        for (int u = bx; u < 512 + 32; u += G) {
            if (u < 512) conv_unit(lds, 0, u >> 5, (u & 31) * 64, UB, args.in[5], args.in[14], args.in[15], args.in[16], args.in[17], MIX, tid, wave, lane);
            else conv_unit(lds, 1, u - 512, 0, UB, args.in[5], args.in[14], args.in[15], args.in[16], args.in[17], MIX, tid, wave, lane);
        }
#endif
    }
    SEAM(4);
    if (IN(5)) { typedef EpiRes<false, false> ER; ER E{nullptr, X, XB, SSQP(1), 1.0f};
        STAGGER2(GEMM_PHASE(ER, MIX, Wout, NP, DM, DM, E), (s_res<false, false>(lds, MIX + (size_t)NP * DM, DM, Wout, nullptr, X, XB, SSQS(1), 1.0f, sl, wave, lane))); }
    SEAM(5);
    if (IN(6)) { EpiCQ E{QX, SSQP(1), 0.0625f * LOG2E}; STAGGER2(GEMM_PHASE(EpiCQ, XB, Wcq, NP, DM, DM, E), s_cq(lds, XB + (size_t)NP * DM, Wcq, QX, SSQS(1), 0.0625f * LOG2E, sl, wave, lane)); }
    SEAM(6);
    if (IN(7)) {
        for (int rep = 0; rep < REP_XA; ++rep)
        for (int u = bx; u < 1024 + 128; u += G) {
            if (u < 1024) { const int h = u & 3, qb = u >> 2; const int b = qb >> 4;
                xattn_unit(lds, MKB + (size_t)b * 256 * DM + h * 256, MVB + (size_t)b * 256 * DM + h * 256, false, DM, QX, OX, qb * 128, 128, h, tid, wave, lane); }
            else { const int v = u - 1024, b = v >> 2, h = v & 3;
                xattn_unit(lds, args.in[6] + ((size_t)b * 256 * 4 + h) * 256, args.in[7] + ((size_t)b * 256 * 4 + h) * 256, true, DM, QX, OX, NP + b * 8, 8, h, tid, wave, lane); }
        }
    }
    SEAM(7);
    if (IN(8)) { typedef EpiRes<false, false> ER; ER E{nullptr, X, XB, SSQP(2), 1.0f};
        STAGGER2(GEMM_PHASE(ER, OX, Wco, NP, DM, DM, E), (s_res<false, false>(lds, OX + (size_t)NP * DM, DM, Wco, nullptr, X, XB, SSQS(2), 1.0f, sl, wave, lane))); }
    SEAM(8);
    if (IN(9)) { EpiGU<true> E{ACT, SSQP(2)}; STAGGER2(GEMM_PHASE(EpiGU<true>, XB, Wgu2, NP, 2 * FF, DM, E), s_gu<true>(lds, XB + (size_t)NP * DM, Wgu2, ACT, SSQS(2), sl, wave, lane)); }
    SEAM(9);
    if (IN(10)) { typedef EpiRes<false, false> ER; ER E{nullptr, X, XB, SSQP(3), 0.5f};
        STAGGER2(GEMM_PHASE(ER, ACT, Wd2, NP, DM, FF, E), (s_res<false, false>(lds, ACT + (size_t)NP * FF, FF, Wd2, nullptr, X, XB, SSQS(3), 0.5f, sl, wave, lane))); }
    SEAM(10);
    if (IN(11)) {
        const int gw = bx * NWAVES + wave, NGW = G * NWAVES;
        const float* gf = args.in[29];
        f32x4 gg[4];
#pragma unroll
        for (int j = 0; j < 4; ++j) gg[j] = ((const f32x4*)gf)[lane + 64 * j];
        for (int m = gw; m < MT; m += 2 * NGW) {
            const int m1 = (m + NGW < MT) ? m + NGW : m;
            float ss0, ss1;
            if (m < NP) ss0 = rowss<true>(SSQP(3), m); else { const f32x2 t = ((const f32x2*)(SSQS(3) + (size_t)(m - NP) * 128))[lane]; ss0 = wave_sum(t[0] + t[1]); }
            if (m1 < NP) ss1 = rowss<true>(SSQP(3), m1); else { const f32x2 t = ((const f32x2*)(SSQS(3) + (size_t)(m1 - NP) * 128))[lane]; ss1 = wave_sum(t[0] + t[1]); }
            const float rs0 = rstd_of(ss0), rs1 = rstd_of(ss1);
            f32x4* xr0 = (f32x4*)(X + (size_t)m * DM) + lane; f32x4* xr1 = (f32x4*)(X + (size_t)m1 * DM) + lane;
            const u32x2* br0 = (const u32x2*)(XB + (size_t)m * DM) + lane; const u32x2* br1 = (const u32x2*)(XB + (size_t)m1 * DM) + lane;
            u32x2 w0[4], w1[4];
#pragma unroll
            for (int j = 0; j < 4; ++j) { w0[j] = br0[64 * j]; w1[j] = br1[64 * j]; }
#pragma unroll
            for (int j = 0; j < 4; ++j) {
                const f32x4 v0 = (f32x4){bflo(w0[j].x), bfhi(w0[j].x), bflo(w0[j].y), bfhi(w0[j].y)}, v1 = (f32x4){bflo(w1[j].x), bfhi(w1[j].x), bflo(w1[j].y), bfhi(w1[j].y)};
                xr0[64 * j] = v0 * rs0 * gg[j]; if (m1 != m) xr1[64 * j] = v1 * rs1 * gg[j]; }
        }
    }
#undef IN
#undef SEAM
}

#ifndef MK_N_LAUNCHES
#define MK_N_LAUNCHES 1
#endif
extern "C" void kernel_launch(void* const* d_in, const int* in_sizes, int n_in, void* d_out, int out_size, void* d_ws, size_t ws_size, hipStream_t stream) {
    static int grid = 0;
    if (grid == 0) {
        if (n_in != 30 || (size_t)out_size != O_END || ws_size < WS_END) { fprintf(stderr, "kernel_launch: unexpected sizes: n_in %d out %d ws %zu\n", n_in, out_size, ws_size); grid = -1; return; }
        int dev = 0, cus = 0, per_cu = 0;
        hipGetDevice(&dev); hipDeviceGetAttribute(&cus, hipDeviceAttributeMultiprocessorCount, dev);
        if (hipFuncSetAttribute((const void*)fwd_megakernel, hipFuncAttributeMaxDynamicSharedMemorySize, LDS_BYTES) != hipSuccess) { fprintf(stderr, "kernel_launch: hipFuncSetAttribute failed\n"); grid = -1; return; }
        if (hipOccupancyMaxActiveBlocksPerMultiprocessor(&per_cu, (const void*)fwd_megakernel, NTHREADS, LDS_BYTES) != hipSuccess || per_cu < 1) { fprintf(stderr, "kernel_launch: occupancy query says %d blocks per CU\n", per_cu); grid = -1; (void)hipGetLastError(); return; }
        grid = cus;
        if (grid > 256) grid = 256;
    }
    if (grid < 0) return;
    Args a{};
    for (int i = 0; i < 30; ++i) a.in[i] = (const float*)d_in[i];
    a.out = (float*)d_out; a.ws = (unsigned char*)d_ws;
#if MK_N_LAUNCHES == 1
    a.ph_lo = 0; a.ph_hi = 12;
    if (hipMemsetAsync((char*)d_ws + WS_BAR, 0, XCD_BAR_WORDS * sizeof(unsigned), stream) != hipSuccess) { fprintf(stderr, "kernel_launch: hipMemsetAsync of the barrier words failed; nothing launched\n"); return; }
    hipLaunchKernelGGL(fwd_megakernel, dim3(grid), dim3(NTHREADS), LDS_BYTES, stream, a);
    const hipError_t e = hipPeekAtLastError();
    if (e != hipSuccess) fprintf(stderr, "kernel_launch: launch failed: %s (grid %d)\n", hipGetErrorString(e), grid);
#else
    for (int p = 0; p < 12; ++p) { a.ph_lo = p; a.ph_hi = p + 1; hipLaunchKernelGGL(fwd_megakernel, dim3(grid), dim3(NTHREADS), LDS_BYTES, stream, a); }
#endif
}
```

```cpp
#include <hip/hip_runtime.h>
#include <cstdio>
#include <cstdint>
namespace pg8 {
#define PG8_LAS __attribute__((address_space(3)))
typedef unsigned short bf16_t;
typedef short bf16x8 __attribute__((ext_vector_type(8)));
typedef float f32x4 __attribute__((ext_vector_type(4)));
typedef unsigned u32x4 __attribute__((ext_vector_type(4)));
constexpr int BM = 256, BK = 64, HALF = 128, HTB = HALF * BK * 2  , STAGE_BYTES = 8 * HTB, NXCD = 8, WGM = 8;

__host__ __device__ __forceinline__ int lds_byte(int r, int c) { const int st = (r >> 4) * 2 + (c >> 5), rr = r & 15, cc = c & 31, ob = rr * 64 + cc * 2; return st * 1024 + (ob ^ (((ob >> 9) & 1) << 5)); }
__host__ __device__ __forceinline__ void stage_rc(int b, int& R, int& C) { const int st = b / 1024, sb = b % 1024, swz = sb ^ (((sb >> 9) & 1) << 5); R = (st >> 1) * 16 + swz / 64; C = (st & 1) * 32 + (swz % 64) / 2; }
__host__ __device__ __forceinline__ int perm32(int rho) { const int n = rho >> 4, i = rho & 15; return 8 * (i >> 2) + 4 * n + (i & 3); }

struct Unit { int pm, pn; };
struct Gemm { const bf16_t* A; const bf16_t* Bt; int M, N, K; };

struct StaticOrder {
    int nM, nN, nwg, G, c;
    __host__ __device__ void init(int M, int N, int G_, int c_) { nM = M / BM; nN = N / BM; nwg = nM * nN; G = G_; c = c_; }
    __host__ __device__ bool next(int i, Unit& u) const {
        const long L = (long)i * G + c; if (L >= nwg) return false;
        int wgid = (int)L; { const int q = nwg / NXCD, r = nwg % NXCD, xcd = wgid % NXCD, off = wgid / NXCD; wgid = (xcd < r ? xcd * (q + 1) : r * (q + 1) + (xcd - r) * q) + off; }
        const int nig = WGM * nN, gid = wgid / nig, fm = gid * WGM, gsz = (nM - fm) < WGM ? (nM - fm) : WGM;
        u.pm = fm + ((wgid % nig) % gsz); u.pn = (wgid % nig) / gsz; return true;
    }
    __device__ __forceinline__ void a_ready(const Unit&) const {}
    __device__ __forceinline__ void done(const Unit&) const {}
};

__device__ __forceinline__ unsigned cvt_pk_bf16(float lo, float hi) { unsigned r; asm volatile("v_cvt_pk_bf16_f32 %0, %1, %2" : "=v"(r) : "v"(lo), "v"(hi)); return r; }
template <class Epi, class Sched, bool ALIGN_EPI = false, bool SP2 = false>
__device__ __forceinline__ void gemm_phase(PG8_LAS unsigned char* lds, const Gemm g, const Sched& S, const Epi& E) {
    const int tid = threadIdx.x, wid = __builtin_amdgcn_readfirstlane(tid >> 6), lane = tid & 63, wr = wid >> 2, wc = wid & 3, fr = lane & 15, fq = lane >> 4;
    const int K = g.K, nt = K / BK;
    unsigned voffA[2], voffB[2];
#pragma unroll
    for (int i = 0; i < 2; ++i) { int R, C; stage_rc(tid * 16 + i * 8192, R, C); const int Rb = Epi::PERM ? ((R & ~31) + perm32(R & 31)) : R;
        voffA[i] = (unsigned)(R * K + C) * 2u; voffB[i] = (unsigned)(Rb * K + C) * 2u; }
    const size_t kstep = (size_t)(BK * 2);
    const size_t hstep = (size_t)HALF * K * 2;
    const size_t tstep = 2 * hstep;
    const unsigned ldsw = (unsigned)wid * 1024u;
    const int aoff = lds_byte(wr * 64 + fr, fq * 8), boff = lds_byte(wc * 32 + fr, fq * 8);
#define PG8_SA(b, h) (((b) * 2 + (h)) * HTB)
#define PG8_SB(b, h) ((4 + (b) * 2 + (h)) * HTB)
#define PG8_STAGE(bufoff, gbase, voff) do { _Pragma("unroll") for (int _i = 0; _i < 2; ++_i) \
        __builtin_amdgcn_global_load_lds((const unsigned*)((const char*)(gbase) + (voff)[_i]), (PG8_LAS unsigned*)(lds + (bufoff) + ldsw + _i * 8192), 16, 0, 0); } while (0)
#define PG8_LDA(dst, b, h) do { _Pragma("unroll") for (int m = 0; m < 4; ++m) _Pragma("unroll") for (int k = 0; k < 2; ++k) dst[m][k] = *(const PG8_LAS bf16x8*)(lds + PG8_SA(b, h) + aoff + m * 2048 + k * 1024); } while (0)
#define PG8_LDB(dst, b, h) do { _Pragma("unroll") for (int n = 0; n < 2; ++n) _Pragma("unroll") for (int k = 0; k < 2; ++k) dst[n][k] = *(const PG8_LAS bf16x8*)(lds + PG8_SB(b, h) + boff + n * 2048 + k * 1024); } while (0)
#define PG8_MMA(ai, bj, At, Bt) do { __builtin_amdgcn_s_setprio(1); _Pragma("unroll") for (int m = 0; m < 4; ++m) _Pragma("unroll") for (int n = 0; n < 2; ++n) _Pragma("unroll") for (int k = 0; k < 2; ++k) \
        acc[ai][bj][m][n] = __builtin_amdgcn_mfma_f32_16x16x32_bf16(Bt[n][k], At[m][k], acc[ai][bj][m][n], 0, 0, 0); __builtin_amdgcn_s_setprio(0); } while (0)
#define PG8_WAIT_V(n) asm volatile("s_waitcnt vmcnt(" #n ")" ::: "memory")
#define PG8_WAIT_L(n) asm volatile("s_waitcnt lgkmcnt(" #n ")" ::: "memory")
#define PG8_BAR __builtin_amdgcn_s_barrier()
#define PG8_SCHED __builtin_amdgcn_sched_barrier(0)
    Unit cur, nxt; int ui = 0;
    if (!S.next(0, cur)) return;
    f32x4 acc[2][2][4][2];
#pragma unroll
    for (int a = 0; a < 2; ++a)
#pragma unroll
        for (int b = 0; b < 2; ++b)
#pragma unroll
            for (int m = 0; m < 4; ++m)
#pragma unroll
                for (int n = 0; n < 2; ++n) acc[a][b][m][n] = (f32x4){0.f, 0.f, 0.f, 0.f};
    bf16x8 At[4][2], B0[2][2], B1[2][2];
    const char* cA = (const char*)g.A + (size_t)cur.pm * tstep; const char* cB = (const char*)g.Bt + (size_t)cur.pn * tstep;
    S.a_ready(cur);
    if constexpr (SP2) {
        PG8_STAGE(PG8_SB(0, 0), cB, voffB); PG8_STAGE(PG8_SB(0, 1), cB + hstep, voffB); PG8_STAGE(PG8_SA(0, 0), cA, voffA); PG8_STAGE(PG8_SA(0, 1), cA + hstep, voffA);
        if (wr == 1) PG8_BAR;
        PG8_WAIT_V(2); PG8_BAR;
        PG8_STAGE(PG8_SB(1, 0), cB + kstep, voffB); PG8_STAGE(PG8_SA(1, 0), cA + kstep, voffA); PG8_STAGE(PG8_SB(1, 1), cB + hstep + kstep, voffB);
        PG8_WAIT_V(6); PG8_BAR;
    } else {
        PG8_STAGE(PG8_SB(0, 0), cB, voffB); PG8_STAGE(PG8_SA(0, 0), cA, voffA); PG8_STAGE(PG8_SB(0, 1), cB + hstep, voffB); PG8_STAGE(PG8_SA(0, 1), cA + hstep, voffA);
        if (wr == 1) PG8_BAR;
        PG8_WAIT_V(4); PG8_BAR;
        PG8_STAGE(PG8_SB(1, 0), cB + kstep, voffB); PG8_STAGE(PG8_SA(1, 0), cA + kstep, voffA); PG8_STAGE(PG8_SB(1, 1), cB + hstep + kstep, voffB);
        PG8_WAIT_V(6); PG8_BAR;
    }
    for (;;) {
        const bool has_next = S.next(ui + 1, nxt);
        const char* nA = has_next ? (const char*)g.A + (size_t)nxt.pm * tstep : cA; const char* nB = has_next ? (const char*)g.Bt + (size_t)nxt.pn * tstep : cB;
        for (int t = 0; t < nt; t += 2) {
            const bool last = (t == nt - 2);
            const char* a1 = cA + (size_t)(t + 1) * kstep;
            const char* a2 = last ? nA : cA + (size_t)(t + 2) * kstep; const char* b2 = last ? nB : cB + (size_t)(t + 2) * kstep;
            const char* a3 = a2 + kstep; const char* b3 = b2 + kstep;
            if (last && has_next) S.a_ready(nxt);
            if constexpr (SP2) {
            PG8_LDB(B0, 0, 0); PG8_LDB(B1, 0, 1); PG8_SCHED; PG8_LDA(At, 0, 0); PG8_STAGE(PG8_SA(1, 1), a1 + hstep, voffA);
            PG8_WAIT_V(8); PG8_WAIT_L(0); PG8_BAR; PG8_MMA(0, 0, At, B0); PG8_MMA(0, 1, At, B1); PG8_BAR; PG8_SCHED;
            PG8_LDA(At, 0, 1); PG8_STAGE(PG8_SB(0, 0), b2, voffB); PG8_STAGE(PG8_SB(0, 1), b2 + hstep, voffB); PG8_STAGE(PG8_SA(0, 0), a2, voffA);
            PG8_WAIT_V(8); PG8_WAIT_L(0); PG8_BAR; PG8_MMA(1, 0, At, B0); PG8_MMA(1, 1, At, B1); PG8_BAR; PG8_SCHED;
            PG8_LDB(B0, 1, 0); PG8_LDB(B1, 1, 1); PG8_SCHED; PG8_LDA(At, 1, 0); PG8_STAGE(PG8_SA(0, 1), a2 + hstep, voffA);
            PG8_WAIT_V(8); PG8_WAIT_L(0); PG8_BAR; PG8_MMA(0, 0, At, B0); PG8_MMA(0, 1, At, B1); PG8_BAR; PG8_SCHED;
            PG8_LDA(At, 1, 1); PG8_STAGE(PG8_SB(1, 0), b3, voffB); PG8_STAGE(PG8_SB(1, 1), b3 + hstep, voffB); PG8_STAGE(PG8_SA(1, 0), a3, voffA);
            PG8_WAIT_V(8); PG8_WAIT_L(0); PG8_BAR; PG8_MMA(1, 0, At, B0); PG8_MMA(1, 1, At, B1); PG8_BAR; PG8_SCHED;
            } else {
            PG8_LDB(B0, 0, 0); PG8_SCHED; PG8_LDA(At, 0, 0); PG8_STAGE(PG8_SA(1, 1), a1 + hstep, voffA);
            PG8_WAIT_L(8); PG8_BAR; PG8_WAIT_L(0); PG8_MMA(0, 0, At, B0); PG8_BAR; PG8_SCHED;
            PG8_LDB(B1, 0, 1); PG8_STAGE(PG8_SB(0, 0), b2, voffB);
            PG8_BAR; PG8_WAIT_L(0); PG8_MMA(0, 1, At, B1); PG8_BAR;
            PG8_LDA(At, 0, 1); PG8_STAGE(PG8_SA(0, 0), a2, voffA);
            PG8_BAR; PG8_WAIT_L(0); PG8_MMA(1, 0, At, B0); PG8_BAR; PG8_SCHED;
            PG8_STAGE(PG8_SB(0, 1), b2 + hstep, voffB);
            PG8_WAIT_V(6); PG8_BAR; PG8_MMA(1, 1, At, B1); PG8_BAR;
            PG8_LDB(B0, 1, 0); PG8_SCHED; PG8_LDA(At, 1, 0); PG8_STAGE(PG8_SA(0, 1), a2 + hstep, voffA);
            PG8_WAIT_L(8); PG8_BAR; PG8_WAIT_L(0); PG8_MMA(0, 0, At, B0); PG8_BAR; PG8_SCHED;
            PG8_LDB(B1, 1, 1); PG8_STAGE(PG8_SB(1, 0), b3, voffB);
            PG8_BAR; PG8_WAIT_L(0); PG8_MMA(0, 1, At, B1); PG8_BAR;
            PG8_LDA(At, 1, 1); PG8_STAGE(PG8_SA(1, 0), a3, voffA);
            PG8_BAR; PG8_WAIT_L(0); PG8_MMA(1, 0, At, B0); PG8_BAR; PG8_SCHED;
            PG8_STAGE(PG8_SB(1, 1), b3 + hstep, voffB);
            PG8_WAIT_V(6); PG8_BAR; PG8_MMA(1, 1, At, B1); PG8_BAR;
            }
        }
        if constexpr (ALIGN_EPI) { if (wr == 0) PG8_BAR; }
        if constexpr (!Epi::AFTER_DRAIN) { E(acc, cur, wr, wc, fr, fq); S.done(cur); }
        if (!has_next) break;
#pragma unroll
        for (int a = 0; a < 2; ++a)
#pragma unroll
            for (int b = 0; b < 2; ++b)
#pragma unroll
                for (int m = 0; m < 4; ++m)
#pragma unroll
                    for (int n = 0; n < 2; ++n) acc[a][b][m][n] = (f32x4){0.f, 0.f, 0.f, 0.f};
        cur = nxt; cA = nA; cB = nB; ++ui;
        if constexpr (ALIGN_EPI) { if (wr == 1) PG8_BAR; }
    }
    PG8_WAIT_V(0);
    if constexpr (!ALIGN_EPI) { if (wr == 0) PG8_BAR; }
    PG8_BAR;
    if constexpr (Epi::AFTER_DRAIN) { E.fused(acc, cur, wr, wc, fr, fq, lds, wid, lane); S.done(cur); }
#undef PG8_SA
#undef PG8_SB
#undef PG8_STAGE
#undef PG8_LDA
#undef PG8_LDB
#undef PG8_MMA
#undef PG8_WAIT_V
#undef PG8_WAIT_L
#undef PG8_BAR
#undef PG8_SCHED
}
}

#define LAS __attribute__((address_space(3)))
typedef unsigned short bf16_t;
typedef short bf16x8 __attribute__((ext_vector_type(8)));
typedef short s16x4 __attribute__((ext_vector_type(4)));
typedef float f32x4 __attribute__((ext_vector_type(4)));
typedef float f32x2 __attribute__((ext_vector_type(2)));
typedef unsigned u32x4 __attribute__((ext_vector_type(4)));
typedef unsigned u32x2 __attribute__((ext_vector_type(2)));

constexpr int DM = 1024, NP = 32768, NS = 256, MT = NP + NS, SEQ = 2048, FF = 2816, NMEMROWS = 4096;
constexpr float EPS = 1e-6f, LOG2E = 1.4426950408889634f;
constexpr int NWAVES = 8, NTHREADS = 512;
constexpr int LDS_BYTES = 147456;
constexpr size_t O_Y = 0, O_YS = 33554432, O_WKP = 33816576, O_WVP = 50593792, O_CP = 67371008, O_MKP = 67616768, O_MVP = 71811072,
                 O_WKS = 76005376, O_WVS = 76136448, O_CS = 76267520, O_END = 76759040;
constexpr size_t MiB = 1u << 20;
constexpr size_t WS_SSQ0 = 0, WS_SSQM = 256 * 1024, WS_SSQ = 512 * 1024;
constexpr size_t WS_BAR = 1536 * 1024;
constexpr size_t WS_WGU1 = 2 * MiB, WS_WD1 = 14 * MiB, WS_WIN = 20 * MiB, WS_WOUT = 26 * MiB, WS_WCQ = 28 * MiB, WS_WCKV = 30 * MiB, WS_WCO = 34 * MiB,
                 WS_WGU2 = 36 * MiB, WS_WD2 = 48 * MiB;
constexpr size_t WS_XB = 56 * MiB, WS_MEMB = 122 * MiB, WS_MKB = 130 * MiB, WS_MVB = 138 * MiB;
constexpr size_t WS_QB = 148 * MiB, WS_KB = 181 * MiB, WS_VB = 214 * MiB, WS_UB = 247 * MiB, WS_MIX = 280 * MiB, WS_QX = 345 * MiB, WS_OX = 410 * MiB, WS_END = 485 * MiB;
static_assert(WS_VB - WS_KB == WS_KB - WS_QB, "QB|KB|VB spacing");
constexpr size_t WS_SSQP = 476 * MiB, WS_SSQS = 484 * MiB;
constexpr size_t WS_ACT = 148 * MiB;

struct Args { const float* in[30]; float* out; unsigned char* ws; int ph_lo, ph_hi; };

__device__ __forceinline__ unsigned pk2(float lo, float hi) { return pg8::cvt_pk_bf16(lo, hi); }
__device__ __forceinline__ float bflo(unsigned u) { return __uint_as_float(u << 16); }
__device__ __forceinline__ float bfhi(unsigned u) { return __uint_as_float(u & 0xffff0000u); }
__device__ __forceinline__ float fexp2(float x) { return __builtin_amdgcn_exp2f(x); }
__device__ __forceinline__ float frcp(float x) { return __builtin_amdgcn_rcpf(x); }
__device__ __forceinline__ float silu_f(float x) { return x * frcp(1.0f + fexp2(-x * LOG2E)); }
__device__ __forceinline__ float sigm_f(float x) { return frcp(1.0f + fexp2(-x * LOG2E)); }
__device__ __forceinline__ float wave_sum(float v) {
#pragma unroll
    for (int o = 1; o < 64; o <<= 1) v += __shfl_xor(v, o);
    return v;
}
__device__ __forceinline__ float rstd_of(float ssq) { return __builtin_amdgcn_rsqf(ssq * (1.0f / 1024.0f) + EPS); }

template <bool PART> __device__ __forceinline__ float rowss4(const float* p, int row, int fq) {
    if (!PART) return p[row];
    const f32x4 a = ((const f32x4*)(p + (size_t)row * 16))[fq];
    float v = (a[0] + a[1]) + (a[2] + a[3]);
    v += __shfl_xor(v, 16); v += __shfl_xor(v, 32);
    return v;
}
template <bool PART> __device__ __forceinline__ float rowss(const float* p, int row) {
    if (!PART) return p[row];
    const f32x4* q = (const f32x4*)(p + (size_t)row * 16); const f32x4 a = q[0], b = q[1], c = q[2], d = q[3];
    return ((a[0] + a[1]) + (a[2] + a[3])) + ((b[0] + b[1]) + (b[2] + b[3])) + ((c[0] + c[1]) + (c[2] + c[3])) + ((d[0] + d[1]) + (d[2] + d[3]));
}
__device__ __forceinline__ float samp_ss(const float* ps, int rr, int fq) {
    const f32x4* q = (const f32x4*)(ps + (size_t)rr * 128 + fq * 32); f32x4 t = (f32x4){0.f, 0.f, 0.f, 0.f};
#pragma unroll
    for (int i = 0; i < 8; ++i) t = t + q[i];
    float v = (t[0] + t[1]) + (t[2] + t[3]);
    v += __shfl_xor(v, 16); v += __shfl_xor(v, 32);
    return v;
}
using pg8::Unit;
template <bool PART> struct EpiGU {
    static constexpr bool PERM = true, AFTER_DRAIN = false;
    bf16_t* ACT; const float* ssq;
    __device__ __forceinline__ void operator()(const f32x4 (&acc)[2][2][4][2], const Unit& u, int wr, int wc, int fr, int fq) const {
        const int row0 = u.pm * 256 + wr * 64 + fr; const int col0 = u.pn * 128 + wc * 32 + 8 * fq;
        float rsv[8];
#pragma unroll
        for (int i = 0; i < 8; ++i) rsv[i] = rowss4<PART>(ssq, row0 + (i >> 2) * 128 + (i & 3) * 16, fq);
#pragma unroll
        for (int ai = 0; ai < 2; ++ai)
#pragma unroll
            for (int m = 0; m < 4; ++m) {
                const int row = row0 + ai * 128 + m * 16; const float rs = rstd_of(rsv[ai * 4 + m]);
                float v[8];
#pragma unroll
                for (int n = 0; n < 2; ++n)
#pragma unroll
                    for (int e = 0; e < 4; ++e) { const float g = acc[ai][0][m][n][e] * rs, up = acc[ai][1][m][n][e] * rs; v[n * 4 + e] = silu_f(g) * up; }
                u32x4 w; w.x = pk2(v[0], v[1]); w.y = pk2(v[2], v[3]); w.z = pk2(v[4], v[5]); w.w = pk2(v[6], v[7]);
                *(u32x4*)(ACT + (size_t)row * FF + col0) = w;
            }
    }
};
template <bool BASE_F32, bool OUT_F32> struct EpiRes {
    static constexpr bool PERM = true, AFTER_DRAIN = false;
    const float* base_p; float* X; bf16_t* XB; float* ssq; float scale;
    __device__ __forceinline__ void operator()(const f32x4 (&acc)[2][2][4][2], const Unit& u, int wr, int wc, int fr, int fq) const {
        const int row0 = u.pm * 256 + wr * 64 + fr; const int col0 = u.pn * 256 + wc * 32 + 8 * fq;
#pragma unroll
        for (int ai = 0; ai < 2; ++ai) {
            f32x4 pre[4][2][2];
#pragma unroll
            for (int m = 0; m < 4; ++m)
#pragma unroll
                for (int bj = 0; bj < 2; ++bj) {
                    const size_t off = (size_t)(row0 + ai * 128 + m * 16) * DM + col0 + bj * 128;
                    if (BASE_F32) { pre[m][bj][0] = *(const f32x4*)(base_p + off); pre[m][bj][1] = *(const f32x4*)(base_p + off + 4); }
                    else { const u32x4 w = *(const u32x4*)(XB + off); pre[m][bj][0] = (f32x4){bflo(w.x), bfhi(w.x), bflo(w.y), bfhi(w.y)}; pre[m][bj][1] = (f32x4){bflo(w.z), bfhi(w.z), bflo(w.w), bfhi(w.w)}; }
                }
            asm volatile("" ::: "memory");
#pragma unroll
            for (int m = 0; m < 4; ++m) {
                const int row = row0 + ai * 128 + m * 16;
                float sq = 0.f;
#pragma unroll
                for (int bj = 0; bj < 2; ++bj) {
                    const size_t off = (size_t)row * DM + col0 + bj * 128;
                    const f32x4 v0 = pre[m][bj][0] + acc[ai][bj][m][0] * scale, v1 = pre[m][bj][1] + acc[ai][bj][m][1] * scale;
                    if (OUT_F32) { *(f32x4*)(X + off) = v0; *(f32x4*)(X + off + 4) = v1; }
                    else { u32x4 w; w.x = pk2(v0[0], v0[1]); w.y = pk2(v0[2], v0[3]); w.z = pk2(v1[0], v1[1]); w.w = pk2(v1[2], v1[3]); *(u32x4*)(XB + off) = w; }
                    sq += ((v0[0] * v0[0] + v0[1] * v0[1]) + (v0[2] * v0[2] + v0[3] * v0[3])) + ((v1[0] * v1[0] + v1[1] * v1[1]) + (v1[2] * v1[2] + v1[3] * v1[3]));
                }
                sq += __shfl_xor(sq, 16); sq += __shfl_xor(sq, 32);
                if (fq == 0) ssq[(size_t)row * 16 + u.pn * 4 + wc] = sq;
            }
        }
    }
};
struct EpiWin {
    static constexpr bool PERM = true, AFTER_DRAIN = false;
    bf16_t *QB, *KB, *VB, *UB; float* out; const float* ssq;
    __device__ __forceinline__ void operator()(const f32x4 (&acc)[2][2][4][2], const Unit& u, int wr, int wc, int fr, int fq) const {
        const int row0 = u.pm * 256 + wr * 64 + fr; const int pn = u.pn;
        const bool samp = u.pm >= 128;
        float rsv[8];
#pragma unroll
        for (int i = 0; i < 8; ++i) rsv[i] = rowss4<true>(ssq, row0 + (i >> 2) * 128 + (i & 3) * 16, fq);
        if (pn < 6) {
            const int sec = pn >> 1;
            bf16_t* B16 = QB + (size_t)sec * ((WS_KB - WS_QB) / 2) + (pn & 1) * 256 + wc * 32 + 8 * fq;
            const size_t fsec = sec ? (size_t)(sec - 1) : 0;
            float* fo = out + (samp ? (O_WKS - (size_t)NP * 512) + fsec * (O_WVS - O_WKS) : O_WKP + fsec * (O_WVP - O_WKP)) + (pn & 1) * 256 + wc * 32 + 8 * fq;
            const float qs = sec == 0 ? (0.125f * LOG2E) : 1.0f;
#pragma unroll
            for (int ai = 0; ai < 2; ++ai)
#pragma unroll
                for (int m = 0; m < 4; ++m) {
                    const int row = row0 + ai * 128 + m * 16; const float sc = rstd_of(rsv[ai * 4 + m]) * qs;
#pragma unroll
                    for (int bj = 0; bj < 2; ++bj) {
                        const int col = bj * 128;
                        const f32x4 v0 = acc[ai][bj][m][0] * sc, v1 = acc[ai][bj][m][1] * sc;
                        if (sec) { __builtin_nontemporal_store(v0, (f32x4*)(fo + (size_t)row * 512 + col)); __builtin_nontemporal_store(v1, (f32x4*)(fo + (size_t)row * 512 + col + 4)); }
                        u32x4 w; w.x = pk2(v0[0], v0[1]); w.y = pk2(v0[2], v0[3]); w.z = pk2(v1[0], v1[1]); w.w = pk2(v1[2], v1[3]); *(u32x4*)(B16 + (size_t)row * 512 + col) = w;
                    }
                }
        } else {
            const int c0 = (pn - 6) * 128 + wc * 32 + 8 * fq;
#pragma unroll
            for (int ai = 0; ai < 2; ++ai)
#pragma unroll
                for (int m = 0; m < 4; ++m) {
                    const int row = row0 + ai * 128 + m * 16; const float rs = rstd_of(rsv[ai * 4 + m]);
                    float* fo = nullptr;
                    if (!samp) { const int sq = row & 2047; if (sq >= 2018) fo = out + O_CP + ((size_t)(row >> 11) * 30 + (sq - 2018)) * 512 + c0; }
                    else { const int rr = row - NP; fo = out + O_CS + ((size_t)(rr >> 3) * 30 + 22 + (rr & 7)) * 512 + c0; }
                    f32x4 v[2];
#pragma unroll
                    for (int n = 0; n < 2; ++n) {
                        const f32x4 a = acc[ai][0][m][n] * rs, g = acc[ai][1][m][n] * rs;
#pragma unroll
                        for (int e = 0; e < 4; ++e) v[n][e] = a[e] * sigm_f(g[e]);
                    }
                    if (fo) { *(f32x4*)(fo) = v[0]; *(f32x4*)(fo + 4) = v[1]; }
                    u32x4 w; w.x = pk2(v[0][0], v[0][1]); w.y = pk2(v[0][2], v[0][3]); w.z = pk2(v[1][0], v[1][1]); w.w = pk2(v[1][2], v[1][3]); *(u32x4*)(UB + (size_t)row * 512 + c0) = w;
                }
        }
    }
};
struct EpiCQ {
    static constexpr bool PERM = true, AFTER_DRAIN = false;
    bf16_t* O; const float* ssq; float scale;
    __device__ __forceinline__ void operator()(const f32x4 (&acc)[2][2][4][2], const Unit& u, int wr, int wc, int fr, int fq) const {
        const int row0 = u.pm * 256 + wr * 64 + fr; const int col0 = u.pn * 256 + wc * 32 + 8 * fq;
        float rsv[8];
#pragma unroll
        for (int i = 0; i < 8; ++i) rsv[i] = rowss4<true>(ssq, row0 + (i >> 2) * 128 + (i & 3) * 16, fq);
#pragma unroll
        for (int ai = 0; ai < 2; ++ai)
#pragma unroll
            for (int m = 0; m < 4; ++m) {
                const int row = row0 + ai * 128 + m * 16; const float rs = rstd_of(rsv[ai * 4 + m]) * scale;
#pragma unroll
                for (int bj = 0; bj < 2; ++bj) {
                    const f32x4 v0 = acc[ai][bj][m][0] * rs, v1 = acc[ai][bj][m][1] * rs;
                    u32x4 w; w.x = pk2(v0[0], v0[1]); w.y = pk2(v0[2], v0[3]); w.z = pk2(v1[0], v1[1]); w.w = pk2(v1[2], v1[3]);
                    *(u32x4*)(O + (size_t)row * DM + col0 + bj * 128) = w;
                }
            }
    }
};
struct EpiMemKV {
    static constexpr bool PERM = true, AFTER_DRAIN = false;
    bf16_t *MKB, *MVB; float* out; const float* ssq;
    __device__ __forceinline__ void operator()(const f32x4 (&acc)[2][2][4][2], const Unit& u, int wr, int wc, int fr, int fq) const {
        const int row0 = u.pm * 256 + wr * 64 + fr; const bool isv = u.pn >= 4;
        bf16_t* B16 = isv ? MVB : MKB; float* fo = out + (isv ? O_MVP : O_MKP);
        float rsv[8];
#pragma unroll
        for (int i = 0; i < 8; ++i) rsv[i] = ssq[row0 + (i >> 2) * 128 + (i & 3) * 16];
#pragma unroll
        for (int ai = 0; ai < 2; ++ai)
#pragma unroll
            for (int m = 0; m < 4; ++m) {
                const int row = row0 + ai * 128 + m * 16; const float rs = rstd_of(rsv[ai * 4 + m]);
#pragma unroll
                for (int bj = 0; bj < 2; ++bj) {
                    const int col = (u.pn & 3) * 256 + bj * 128 + wc * 32 + 8 * fq;
                    const f32x4 v0 = acc[ai][bj][m][0] * rs, v1 = acc[ai][bj][m][1] * rs;
                    __builtin_nontemporal_store(v0, (f32x4*)(fo + (size_t)row * DM + col)); __builtin_nontemporal_store(v1, (f32x4*)(fo + (size_t)row * DM + col + 4));
                    u32x4 w; w.x = pk2(v0[0], v0[1]); w.y = pk2(v0[2], v0[3]); w.z = pk2(v1[0], v1[1]); w.w = pk2(v1[2], v1[3]); *(u32x4*)(B16 + (size_t)row * DM + col) = w;
                }
            }
    }
};

__device__ __forceinline__ int rowmap(int mode, int n0) {
    if (mode == 1) return (n0 >> 7) * 256 + (n0 & 127);
    if (mode == 2) return (n0 >> 7) * 256 + 128 + (n0 & 127);
    if (mode == 3) { if (n0 < 1536) return n0; if (n0 < 2048) { const int c = n0 - 1536; return 1536 + (c >> 7) * 256 + (c & 127); } const int c = n0 - 2048; return 1536 + (c >> 7) * 256 + 128 + (c & 127); }
    return n0;
}
__device__ __forceinline__ void p0_transpose_item(const float* W, int K, int N, bf16_t* WT, int mode, int row_off, const float* gain, LAS float* scr, int item, int lane) {
    const int nblk = N / 32, kb = item / nblk, nb = item % nblk, k0 = 64 * kb, n0 = 32 * nb;
#pragma unroll
    for (int i = 0; i < 32; ++i) { const int kk = 2 * i + (lane >> 5); float v = __builtin_nontemporal_load(W + (size_t)(k0 + kk) * N + n0 + (lane & 31)); if (gain) v *= gain[k0 + kk]; scr[kk * 33 + (lane & 31)] = v; }
    asm volatile("s_waitcnt lgkmcnt(0)" ::: "memory");
    const int c = lane & 7; const int drow0 = row_off + rowmap(mode, n0);
#pragma unroll
    for (int j = 0; j < 4; ++j) { const int n = (lane >> 3) + 8 * j; const LAS float* s = scr + (8 * c) * 33 + n;
        u32x4 o; o.x = pk2(s[0 * 33], s[1 * 33]); o.y = pk2(s[2 * 33], s[3 * 33]); o.z = pk2(s[4 * 33], s[5 * 33]); o.w = pk2(s[6 * 33], s[7 * 33]);
        *(u32x4*)(WT + (size_t)(drow0 + n) * K + k0 + 8 * c) = o; }
    asm volatile("s_waitcnt lgkmcnt(0)" ::: "memory");
}
__device__ __forceinline__ void row_to_bf16(const float* xrow, bf16_t* orow, float* ssq_out, int lane) {
    const f32x4* xr = (const f32x4*)xrow + lane; f32x4 v[4]; float s = 0.f;
#pragma unroll
    for (int j = 0; j < 4; ++j) { v[j] = xr[64 * j]; s += (v[j][0] * v[j][0] + v[j][1] * v[j][1]) + (v[j][2] * v[j][2] + v[j][3] * v[j][3]); }
    s = wave_sum(s);
    u32x2* o8 = (u32x2*)orow + lane;
#pragma unroll
    for (int j = 0; j < 4; ++j) { u32x2 w; w.x = pk2(v[j][0], v[j][1]); w.y = pk2(v[j][2], v[j][3]); o8[64 * j] = w; }
    if (lane == 0) *ssq_out = s;
}

__device__ __forceinline__ void row2_to_bf16(const float* xa, const float* xb, bf16_t* oa, bf16_t* ob, float* sa, float* sb, int lane) {
    const f32x4* pa = (const f32x4*)xa + lane; const f32x4* pb = (const f32x4*)xb + lane; f32x4 va[4], vb[4]; float s0 = 0.f, s1 = 0.f;
#pragma unroll
    for (int j = 0; j < 4; ++j) { va[j] = __builtin_nontemporal_load(pa + 64 * j); vb[j] = __builtin_nontemporal_load(pb + 64 * j); }
#pragma unroll
    for (int j = 0; j < 4; ++j) { s0 += (va[j][0] * va[j][0] + va[j][1] * va[j][1]) + (va[j][2] * va[j][2] + va[j][3] * va[j][3]); s1 += (vb[j][0] * vb[j][0] + vb[j][1] * vb[j][1]) + (vb[j][2] * vb[j][2] + vb[j][3] * vb[j][3]); }
    s0 = wave_sum(s0); s1 = wave_sum(s1);
    u32x2* qa = (u32x2*)oa + lane; u32x2* qb = (u32x2*)ob + lane;
#pragma unroll
    for (int j = 0; j < 4; ++j) { u32x2 w; w.x = pk2(va[j][0], va[j][1]); w.y = pk2(va[j][2], va[j][3]); qa[64 * j] = w; u32x2 z; z.x = pk2(vb[j][0], vb[j][1]); z.y = pk2(vb[j][2], vb[j][3]); qb[64 * j] = z; }
    if (lane == 0) { *sa = s0; *sb = s1; }
}

constexpr int AT_MB_PITCH = 68;
constexpr int AT_MB_BYTES = 256 * AT_MB_PITCH * 4;
constexpr int AT_VP = 144;
constexpr int AT_VS_BYTES = 2 * 32 * AT_VP;
__device__ __forceinline__ s16x4 lds_tr(const LAS unsigned char* p) {
    typedef short v4i16_t __attribute__((ext_vector_type(4)));
    return __builtin_bit_cast(s16x4, __builtin_amdgcn_ds_read_tr16_b64_v4i16((LAS v4i16_t*)p));
}
template <int NQ> __device__ __forceinline__ void attn_tile(LAS float* MBuf, LAS unsigned char* vs, const bf16_t* QB, const bf16_t* KB, const bf16_t* VB, bf16_t* MIX,
                                                            size_t rowb, int h, int p0, int br, int r, int i0, float slope2, int lane) {
    const int fr = lane & 15, fq = lane >> 4, tq = fr >> 2, tp = fr & 3;
    const int sh = 2 * br, L = SEQ >> sh;
    int qi[NQ], qpos[NQ]; bf16x8 q0[NQ], q1[NQ]; float m_run[NQ], l_run[NQ]; f32x4 o[NQ][4];
#pragma unroll
    for (int t = 0; t < NQ; ++t) {
        qi[t] = i0 + 16 * t + fr; qpos[t] = (qi[t] << sh) + r;
        const bf16_t* qp = QB + (rowb + qpos[t]) * 512 + h * 64 + fq * 8;
        q0[t] = *(const bf16x8*)qp; q1[t] = *(const bf16x8*)(qp + 32);
        m_run[t] = -INFINITY; l_run[t] = 0.f;
#pragma unroll
        for (int dt = 0; dt < 4; ++dt) o[t][dt] = (f32x4){0.f, 0.f, 0.f, 0.f};
    }
    const bf16_t* kbase = KB + (rowb + r) * 512 + h * 64 + (lane & 7) * 8;
    const bf16_t* vbase = VB + (rowb + r) * 512 + h * 64 + (lane & 7) * 8;
    int pi_lo = (128 - i0) >> 5; pi_lo = pi_lo < 0 ? 0 : pi_lo;
    bf16x8 kf[4]; u32x4 vv[4];
#define AT_LOAD_PAIR(KF, VV, PI) do { const int kb0_ = i0 - 128 + 32 * (PI); \
        _Pragma("unroll") for (int vi_ = 0; vi_ < 4; ++vi_) { int kj_ = kb0_ + 8 * vi_ + (lane >> 3); kj_ = kj_ < 0 ? 0 : (kj_ > L - 1 ? L - 1 : kj_); \
            KF[vi_] = *(const bf16x8*)(kbase + (size_t)(kj_ << sh) * 512); VV[vi_] = *(const u32x4*)(vbase + (size_t)(kj_ << sh) * 512); } } while (0)
    AT_LOAD_PAIR(kf, vv, pi_lo);
#pragma unroll 1
    for (int pi = pi_lo; pi < 5; ++pi) {
        bf16x8 nkf[4]; u32x4 nvv[4];
        { const int pn = pi + 1 < 5 ? pi + 1 : 4; AT_LOAD_PAIR(nkf, nvv, pn); }
        const int kb0 = i0 - 128 + 32 * pi;
        { LAS unsigned char* vd = vs + (lane >> 3) * AT_VP + (lane & 7) * 16;
#pragma unroll
          for (int vi = 0; vi < 4; ++vi) { *(LAS u32x4*)(vd + 8 * vi * AT_VP) = vv[vi]; *(LAS bf16x8*)(vd + 32 * AT_VP + 8 * vi * AT_VP) = kf[vi]; } }
        bf16x8 kfr[4];
        { const LAS unsigned char* kr = vs + 32 * AT_VP + fr * AT_VP + fq * 16;
          kfr[0] = *(const LAS bf16x8*)kr; kfr[1] = *(const LAS bf16x8*)(kr + 64); kfr[2] = *(const LAS bf16x8*)(kr + 16 * AT_VP); kfr[3] = *(const LAS bf16x8*)(kr + 16 * AT_VP + 64); }
        bf16x8 pf[NQ];
#pragma unroll
        for (int t = 0; t < NQ; ++t) {
            f32x4 sa = (f32x4){0.f, 0.f, 0.f, 0.f}, sb = (f32x4){0.f, 0.f, 0.f, 0.f};
            sa = __builtin_amdgcn_mfma_f32_16x16x32_bf16(kfr[0], q0[t], sa, 0, 0, 0); sa = __builtin_amdgcn_mfma_f32_16x16x32_bf16(kfr[1], q1[t], sa, 0, 0, 0);
            sb = __builtin_amdgcn_mfma_f32_16x16x32_bf16(kfr[2], q0[t], sb, 0, 0, 0); sb = __builtin_amdgcn_mfma_f32_16x16x32_bf16(kfr[3], q1[t], sb, 0, 0, 0);
            float sc[8]; float mx = -INFINITY;
            if (pi >= 1 && pi <= 3 && kb0 >= 0) {
                const float bstep = slope2 * (float)(1 << sh);
                const float b0 = -bstep * (float)(qi[t] - kb0 - 4 * fq), b1 = b0 + 16.0f * bstep;
#pragma unroll
                for (int e = 0; e < 4; ++e) { sc[e] = sa[e] + (b0 + bstep * (float)e); sc[4 + e] = sb[e] + (b1 + bstep * (float)e); mx = fmaxf(mx, fmaxf(sc[e], sc[4 + e])); }
            } else {
#pragma unroll
            for (int e = 0; e < 4; ++e) {
                const int keya = kb0 + 4 * fq + e, da = qi[t] - keya;
                const bool va = (keya >= 0) && (da >= 0) && (da <= 128);
                sc[e] = va ? sa[e] - slope2 * (float)(da << sh) : -INFINITY;
                const int keyb = keya + 16, db = qi[t] - keyb;
                const bool vb = (keyb >= 0) && (db >= 0) && (db <= 128);
                sc[4 + e] = vb ? sb[e] - slope2 * (float)(db << sh) : -INFINITY;
                mx = fmaxf(mx, fmaxf(sc[e], sc[4 + e]));
            }
            }
            mx = fmaxf(mx, __shfl_xor(mx, 16)); mx = fmaxf(mx, __shfl_xor(mx, 32));
            const float m_new = fmaxf(m_run[t], mx);
            const float mref = (m_new == -INFINITY) ? 0.f : m_new;
            const float alpha = fexp2(m_run[t] - mref);
            float p[8]; float ps = 0.f;
#pragma unroll
            for (int e = 0; e < 8; ++e) { p[e] = fexp2(sc[e] - mref); ps += p[e]; }
            l_run[t] = l_run[t] * alpha + ps; m_run[t] = m_new;
#pragma unroll
            for (int dt = 0; dt < 4; ++dt) o[t][dt] = o[t][dt] * alpha;
            u32x4 pw; pw.x = pk2(p[0], p[1]); pw.y = pk2(p[2], p[3]); pw.z = pk2(p[4], p[5]); pw.w = pk2(p[6], p[7]);
            pf[t] = __builtin_bit_cast(bf16x8, pw);
        }
        const LAS unsigned char* tb = vs + (4 * fq + tq) * AT_VP + tp * 8;
#pragma unroll
        for (int dt = 0; dt < 4; ++dt) {
            const s16x4 a = lds_tr(tb + dt * 32), bb = lds_tr(tb + 16 * AT_VP + dt * 32);
            const bf16x8 vf = (bf16x8){a[0], a[1], a[2], a[3], bb[0], bb[1], bb[2], bb[3]};
#pragma unroll
            for (int t = 0; t < NQ; ++t) o[t][dt] = __builtin_amdgcn_mfma_f32_16x16x32_bf16(vf, pf[t], o[t][dt], 0, 0, 0);
        }
#pragma unroll
        for (int i = 0; i < 4; ++i) { kf[i] = nkf[i]; vv[i] = nvv[i]; }
    }
#undef AT_LOAD_PAIR
#pragma unroll
    for (int t = 0; t < NQ; ++t) {
        float lr = l_run[t]; lr += __shfl_xor(lr, 16); lr += __shfl_xor(lr, 32);
        const float mr = m_run[t];
        LAS float* mrow = MBuf + (qpos[t] - p0) * AT_MB_PITCH;
        if (br == 0) {
#pragma unroll
            for (int dt = 0; dt < 4; ++dt) *(LAS f32x4*)(mrow + dt * 16 + 4 * fq) = o[t][dt];
            if (fq == 0) { mrow[64] = mr; mrow[65] = lr; }
        } else {
            const float m0 = mrow[64], l0 = mrow[65];
            const float mm = fmaxf(m0, mr); const float a0 = fexp2(m0 - mm), a1 = fexp2(mr - mm);
            const float ll = a0 * l0 + a1 * lr;
            f32x4 om[4];
#pragma unroll
            for (int dt = 0; dt < 4; ++dt) om[dt] = *(LAS f32x4*)(mrow + dt * 16 + 4 * fq) * a0 + o[t][dt] * a1;
            if (br == 1) {
#pragma unroll
                for (int dt = 0; dt < 4; ++dt) *(LAS f32x4*)(mrow + dt * 16 + 4 * fq) = om[dt];
                if (fq == 0) { mrow[64] = mm; mrow[65] = ll; }
            } else {
                const float inv = 1.0f / ll;
                bf16_t* op = MIX + (rowb + qpos[t]) * DM + h * 64 + 4 * fq;
#pragma unroll
                for (int dt = 0; dt < 4; ++dt) { u32x2 w; w.x = pk2(om[dt][0] * inv, om[dt][1] * inv); w.y = pk2(om[dt][2] * inv, om[dt][3] * inv); *(u32x2*)(op + dt * 16) = w; }
            }
        }
    }
}
__device__ __forceinline__ void attn_prompt_unit(LAS unsigned char* lds, const bf16_t* QB, const bf16_t* KB, const bf16_t* VB, bf16_t* MIX, int b, int h, int blk, int wave, int lane) {
    LAS float* MBuf = (LAS float*)lds;
    LAS unsigned char* vs = lds + AT_MB_BYTES + wave * AT_VS_BYTES;
    const int p0 = blk * 256;
    const float slope2 = fexp2(-(float)(h + 1)) * LOG2E;
    const size_t rowb = (size_t)b * SEQ;
    attn_tile<2>(MBuf, vs, QB, KB, VB, MIX, rowb, h, p0, 0, 0, p0 + 32 * wave, slope2, lane);
    __syncthreads();
    attn_tile<2>(MBuf, vs, QB, KB, VB, MIX, rowb, h, p0, 1, wave & 3, (p0 >> 2) + 32 * (wave >> 2), slope2, lane);
    __syncthreads();
#pragma unroll 1
    for (int tt2 = 0; tt2 < 2; ++tt2) attn_tile<1>(MBuf, vs, QB, KB, VB, MIX, rowb, h, p0, 2, 2 * wave + tt2, p0 >> 4, slope2, lane);
    __syncthreads();
}

__device__ __forceinline__ void attn_sample_unit(LAS unsigned char* lds, const bf16_t* QB, const float* cwk, const float* cwv, const float* out, bf16_t* MIX, int b, int h, int wave, int lane) {
    const int t = wave, sub = lane & 15, g = lane >> 4;
    const int row = NP + b * 8 + t;
    const float slope2 = fexp2(-(float)(h + 1)) * LOG2E;
    float q[4];
    { const u32x2 qw = *(const u32x2*)(QB + (size_t)row * 512 + h * 64 + 4 * sub); q[0] = bflo(qw.x); q[1] = bfhi(qw.x); q[2] = bflo(qw.y); q[3] = bfhi(qw.y); }
    float m = -INFINITY, l = 0.f; f32x4 acc = (f32x4){0.f, 0.f, 0.f, 0.f};
#pragma unroll 1
    for (int it0 = 0; it0 < 112; it0 += 16) {
        f32x4 k4[16], v4[16]; float s[16];
#pragma unroll
        for (int i = 0; i < 16; ++i) {
            const int idx = (it0 + i) * 4 + g; const int idc = idx > 386 ? 386 : idx;
            const int br = idc / 129, j = idc - br * 129; const int dist = j << (2 * br);
            const int uu = 2048 + t - dist;
            const size_t offn = (size_t)(b * 8 + (uu - 2048)) * 512 + h * 64 + 4 * sub, offc = ((size_t)(b * 2048 + uu) * 8 + h) * 64 + 4 * sub;
            k4[i] = *(const f32x4*)((uu >= 2048) ? out + O_WKS + offn : cwk + offc);
            v4[i] = *(const f32x4*)((uu >= 2048) ? out + O_WVS + offn : cwv + offc);
        }
        float bm = -INFINITY;
#pragma unroll
        for (int i = 0; i < 16; ++i) {
            const int idx = (it0 + i) * 4 + g; const int idc = idx > 386 ? 386 : idx;
            const int br = idc / 129, j = idc - br * 129; const int dist = j << (2 * br);
            float d = (q[0] * k4[i][0] + q[1] * k4[i][1]) + (q[2] * k4[i][2] + q[3] * k4[i][3]);
            d += __shfl_xor(d, 1); d += __shfl_xor(d, 2); d += __shfl_xor(d, 4); d += __shfl_xor(d, 8);
            d -= slope2 * (float)dist;
            s[i] = idx <= 386 ? d : -INFINITY; bm = fmaxf(bm, s[i]);
        }
        const float m_new = fmaxf(m, bm); const float mref = (m_new == -INFINITY) ? 0.f : m_new;
        const float alpha = fexp2(m - mref);
        l *= alpha; acc = acc * alpha; m = m_new;
#pragma unroll
        for (int i = 0; i < 16; ++i) { const float p = fexp2(s[i] - mref); l += p; acc = acc + v4[i] * p; }
    }
    float mall = fmaxf(m, __shfl_xor(m, 16)); mall = fmaxf(mall, __shfl_xor(mall, 32));
    const float sc = fexp2(m - mall);
    l *= sc; acc = acc * sc;
#pragma unroll
    for (int e = 0; e < 4; ++e) { acc[e] += __shfl_xor(acc[e], 16); acc[e] += __shfl_xor(acc[e], 32); }
    l += __shfl_xor(l, 16); l += __shfl_xor(l, 32);
    if (g == 0) { const float inv = 1.0f / l; u32x2 w; w.x = pk2(acc[0] * inv, acc[1] * inv); w.y = pk2(acc[2] * inv, acc[3] * inv);
        *(u32x2*)(MIX + (size_t)row * DM + h * 64 + 4 * sub) = w; }
}

constexpr int CV_TILE_BYTES = 94 * 1024;
__device__ __forceinline__ void conv_unit(LAS unsigned char* lds, int kind, int b, int p0, const bf16_t* UB, const float* cconv, const float* cw, const float* cb, const float* lng, const float* lnb,
                                          bf16_t* MIX, int tid, int wave, int lane) {
    LAS unsigned* T = (LAS unsigned*)lds;
    LAS float* ST = (LAS float*)(lds + CV_TILE_BYTES);
    if (kind == 0) {
        u32x4 w[12];
#pragma unroll
        for (int i = 0; i < 12; ++i) { const int id = tid + NTHREADS * i, rr = id >> 6, c8 = id & 63; const int pos = p0 - 30 + rr;
            w[i] = (u32x4){0u, 0u, 0u, 0u}; if (id < 94 * 64 && pos >= 0) w[i] = *(const u32x4*)(UB + ((size_t)b * SEQ + pos) * 512 + c8 * 8); }
#pragma unroll
        for (int i = 0; i < 12; ++i) { const int id = tid + NTHREADS * i, rr = id >> 6, c8 = id & 63; if (id < 94 * 64) *(LAS u32x4*)(lds + rr * 1024 + c8 * 16) = w[i]; }
    } else
    for (int id = tid; id < 94 * 64; id += NTHREADS) {
        const int rr = id >> 6, c8 = id & 63; u32x4 w = (u32x4){0u, 0u, 0u, 0u};
        if (rr < 30) { const f32x4* s = (const f32x4*)(cconv + ((size_t)b * 30 + rr) * 512 + c8 * 8); const f32x4 a = s[0], c = s[1];
            w.x = pk2(a[0], a[1]); w.y = pk2(a[2], a[3]); w.z = pk2(c[0], c[1]); w.w = pk2(c[2], c[3]); }
        else if (rr < 38) w = *(const u32x4*)(UB + ((size_t)NP + b * 8 + (rr - 30)) * 512 + c8 * 8);
        *(LAS u32x4*)(lds + rr * 1024 + c8 * 16) = w;
    }
    const int cp = tid & 255, half = tid >> 8, w4 = wave & 3;
    typedef __bf16 bf2_t __attribute__((ext_vector_type(2)));
    unsigned w0[31], w1[31];
#pragma unroll
    for (int j = 0; j < 31; ++j) { const f32x2 ww = *(const f32x2*)(cw + j * 512 + 2 * cp); w0[j] = pk2(ww[0], 0.f); w1[j] = pk2(0.f, ww[1]); }
    const f32x2 cbv = *(const f32x2*)(cb + 2 * cp), gv = *(const f32x2*)(lng + 2 * cp), bv = *(const f32x2*)(lnb + 2 * cp);
    __syncthreads();
    const int nchunks = kind == 0 ? 4 : 1;
    const size_t orow0 = kind == 0 ? (size_t)b * SEQ + p0 : (size_t)NP + b * 8;
#pragma unroll 1
    for (int ch = 0; ch < nchunks; ++ch) {
        float a0[8], a1[8];
#pragma unroll
        for (int pp = 0; pp < 8; ++pp) {
            const int pl = half * 32 + ch * 8 + pp;
            float c0 = cbv[0], c1 = cbv[1];
#pragma unroll
            for (int j = 0; j < 31; ++j) { const unsigned uu = T[(pl + j) * 256 + cp];
                c0 = __builtin_amdgcn_fdot2_f32_bf16(__builtin_bit_cast(bf2_t, uu), __builtin_bit_cast(bf2_t, w0[j]), c0, false);
                c1 = __builtin_amdgcn_fdot2_f32_bf16(__builtin_bit_cast(bf2_t, uu), __builtin_bit_cast(bf2_t, w1[j]), c1, false); }
            a0[pp] = c0; a1[pp] = c1;
            asm volatile("" ::: "memory");
        }
        {
            float r[16];
#pragma unroll
            for (int pp = 0; pp < 8; ++pp) { r[2 * pp] = a0[pp] + a1[pp]; r[2 * pp + 1] = a0[pp] * a0[pp] + a1[pp] * a1[pp]; }
            { const bool bt = (lane & 32) != 0;
#pragma unroll
              for (int i = 0; i < 8; ++i) { const float snd = bt ? r[i] : r[i + 8], kp = bt ? r[i + 8] : r[i]; r[i] = kp + __shfl_xor(snd, 32); } }
            { const bool bt = (lane & 16) != 0;
#pragma unroll
              for (int i = 0; i < 4; ++i) { const float snd = bt ? r[i] : r[i + 4], kp = bt ? r[i + 4] : r[i]; r[i] = kp + __shfl_xor(snd, 16); } }
            { const bool bt = (lane & 8) != 0;
#pragma unroll
              for (int i = 0; i < 2; ++i) { const float snd = bt ? r[i] : r[i + 2], kp = bt ? r[i + 2] : r[i]; r[i] = kp + __shfl_xor(snd, 8); } }
            { const bool bt = (lane & 4) != 0; const float snd = bt ? r[0] : r[1], kp = bt ? r[1] : r[0]; r[0] = kp + __shfl_xor(snd, 4); }
            r[0] += __shfl_xor(r[0], 2); r[0] += __shfl_xor(r[0], 1);
            if ((lane & 3) == 0) { const int v = ((lane >> 5) & 1) * 8 + ((lane >> 4) & 1) * 4 + ((lane >> 3) & 1) * 2 + ((lane >> 2) & 1);
                ST[((half * 8 + (v >> 1)) * 4 + w4) * 2 + (v & 1)] = r[0]; }
        }
        __syncthreads();
        const bool valid = kind == 0 || half == 0;
#pragma unroll
        for (int pp = 0; pp < 8; ++pp) {
            const LAS float* sp = ST + (half * 8 + pp) * 8;
            const float S1 = (sp[0] + sp[2]) + (sp[4] + sp[6]), S2 = (sp[1] + sp[3]) + (sp[5] + sp[7]);
            const float mean = S1 * (1.0f / 512.0f); const float var = S2 * (1.0f / 512.0f) - mean * mean;
            const float rstd = __builtin_amdgcn_rsqf(fmaxf(var, 0.f) + EPS);
            const float y0 = (a0[pp] - mean) * rstd * gv[0] + bv[0], y1 = (a1[pp] - mean) * rstd * gv[1] + bv[1];
            if (valid) *(unsigned*)(MIX + (orow0 + half * 32 + ch * 8 + pp) * DM + 512 + 2 * cp) = pk2(silu_f(y0), silu_f(y1));
        }
        __syncthreads();
    }
}

constexpr int XA_KP = 528, XA_VP = 544;
__device__ __forceinline__ void xattn_unit(LAS unsigned char* lds, const void* Kp, const void* Vp, bool kvf32, int pitch, const bf16_t* QX, bf16_t* OX, int qrow0, int nq, int h, int tid, int wave, int lane) {
    const int fr = lane & 15, fq = lane >> 4;
    if (!kvf32) {
        u32x4 w[16];
#pragma unroll
        for (int i = 0; i < 16; ++i) { const int id = tid + NTHREADS * i, rr = id >> 5, c = id & 31; w[i] = *(const u32x4*)((const bf16_t*)Kp + (size_t)rr * pitch + c * 8); }
#pragma unroll
        for (int i = 0; i < 16; ++i) { const int id = tid + NTHREADS * i, rr = id >> 5, c = id & 31; *(LAS u32x4*)(lds + rr * XA_KP + c * 16) = w[i]; }
    } else {
#pragma unroll 1
        for (int i0 = 0; i0 < 16; i0 += 8) {
            f32x4 fa[8], fd[8];
#pragma unroll
            for (int i = 0; i < 8; ++i) { const int id = tid + NTHREADS * (i0 + i), rr = id >> 5, c = id & 31; const f32x4* sp = (const f32x4*)((const float*)Kp + (size_t)rr * pitch + c * 8); fa[i] = sp[0]; fd[i] = sp[1]; }
#pragma unroll
            for (int i = 0; i < 8; ++i) { const int id = tid + NTHREADS * (i0 + i), rr = id >> 5, c = id & 31; u32x4 w; w.x = pk2(fa[i][0], fa[i][1]); w.y = pk2(fa[i][2], fa[i][3]); w.z = pk2(fd[i][0], fd[i][1]); w.w = pk2(fd[i][2], fd[i][3]);
                *(LAS u32x4*)(lds + rr * XA_KP + c * 16) = w; }
        }
    }
    __syncthreads();
    const bool active = 16 * wave < nq;
    int qr = qrow0 + 16 * wave + fr; if (qr > qrow0 + nq - 1) qr = qrow0 + nq - 1;
    bf16x8 pf[8]; float linv = 0.f;
    if (active) {
        bf16x8 qf[8];
        const bf16_t* qp = QX + (size_t)qr * DM + h * 256 + fq * 8;
#pragma unroll
        for (int ks = 0; ks < 8; ++ks) qf[ks] = *(const bf16x8*)(qp + ks * 32);
        f32x4 s[16]; float mx = -INFINITY;
#pragma unroll
        for (int c = 0; c < 16; ++c) {
            f32x4 a = (f32x4){0.f, 0.f, 0.f, 0.f};
            const LAS unsigned char* kr = lds + (16 * c + fr) * XA_KP + fq * 16;
#pragma unroll
            for (int ks = 0; ks < 8; ++ks) a = __builtin_amdgcn_mfma_f32_16x16x32_bf16(*(const LAS bf16x8*)(kr + ks * 64), qf[ks], a, 0, 0, 0);
            s[c] = a; mx = fmaxf(fmaxf(mx, fmaxf(a[0], a[1])), fmaxf(a[2], a[3]));
        }
        mx = fmaxf(mx, __shfl_xor(mx, 16)); mx = fmaxf(mx, __shfl_xor(mx, 32));
        float l = 0.f;
#pragma unroll
        for (int c = 0; c < 16; ++c) {
#pragma unroll
            for (int e = 0; e < 4; ++e) { s[c][e] = fexp2(s[c][e] - mx); l += s[c][e]; }
        }
        l += __shfl_xor(l, 16); l += __shfl_xor(l, 32); linv = 1.0f / l;
#pragma unroll
        for (int k2 = 0; k2 < 8; ++k2) { u32x4 pw; pw.x = pk2(s[2 * k2][0], s[2 * k2][1]); pw.y = pk2(s[2 * k2][2], s[2 * k2][3]); pw.z = pk2(s[2 * k2 + 1][0], s[2 * k2 + 1][1]); pw.w = pk2(s[2 * k2 + 1][2], s[2 * k2 + 1][3]);
            pf[k2] = __builtin_bit_cast(bf16x8, pw); }
    }
    __syncthreads();
    if (!kvf32) {
        u32x4 w[16];
#pragma unroll
        for (int i = 0; i < 16; ++i) { const int id = tid + NTHREADS * i, rr = id >> 5, c = id & 31; w[i] = *(const u32x4*)((const bf16_t*)Vp + (size_t)rr * pitch + c * 8); }
#pragma unroll
        for (int i = 0; i < 16; ++i) { const int id = tid + NTHREADS * i, rr = id >> 5, c = id & 31; *(LAS u32x4*)(lds + rr * XA_VP + c * 16) = w[i]; }
    } else {
#pragma unroll 1
        for (int i0 = 0; i0 < 16; i0 += 8) {
            f32x4 fa[8], fd[8];
#pragma unroll
            for (int i = 0; i < 8; ++i) { const int id = tid + NTHREADS * (i0 + i), rr = id >> 5, c = id & 31; const f32x4* sp = (const f32x4*)((const float*)Vp + (size_t)rr * pitch + c * 8); fa[i] = sp[0]; fd[i] = sp[1]; }
#pragma unroll
            for (int i = 0; i < 8; ++i) { const int id = tid + NTHREADS * (i0 + i), rr = id >> 5, c = id & 31; u32x4 w; w.x = pk2(fa[i][0], fa[i][1]); w.y = pk2(fa[i][2], fa[i][3]); w.z = pk2(fd[i][0], fd[i][1]); w.w = pk2(fd[i][2], fd[i][3]);
                *(LAS u32x4*)(lds + rr * XA_VP + c * 16) = w; }
        }
    }
    __syncthreads();
    if (active) {
        const int tq = fr >> 2, tp = fr & 3;
        const LAS unsigned char* tb = lds + (4 * fq + tq) * XA_VP + tp * 8;
        const bool wr_ok = 16 * wave + fr < nq;
        bf16_t* op = OX + (size_t)qr * DM + h * 256 + 4 * fq;
#pragma unroll 4
        for (int dt = 0; dt < 16; ++dt) {
            f32x4 o = (f32x4){0.f, 0.f, 0.f, 0.f};
#pragma unroll
            for (int k2 = 0; k2 < 8; ++k2) {
                const s16x4 a = lds_tr(tb + (32 * k2) * XA_VP + dt * 32), bb = lds_tr(tb + (32 * k2 + 16) * XA_VP + dt * 32);
                const bf16x8 vf = (bf16x8){a[0], a[1], a[2], a[3], bb[0], bb[1], bb[2], bb[3]};
                o = __builtin_amdgcn_mfma_f32_16x16x32_bf16(vf, pf[k2], o, 0, 0, 0);
            }
            if (wr_ok) { u32x2 w; w.x = pk2(o[0] * linv, o[1] * linv); w.y = pk2(o[2] * linv, o[3] * linv); *(u32x2*)(op + dt * 16) = w; }
        }
    }
    __syncthreads();
}


constexpr int SG_PITCH = 528;
constexpr int SG_WAVE_BYTES = 32 * SG_PITCH;
template <int NT, int UNR> __device__ __forceinline__ void sgemm(LAS unsigned char* lds, const bf16_t* A, const bf16_t* Bt, int K, const int (&brow)[NT], int wave, int lane, f32x4 (&acc)[2][NT]) {
    static_assert(UNR == 8, "one staged block = 8 k-steps");
    const int fr = lane & 15, fq = lane >> 4;
    LAS unsigned char* st = lds + wave * SG_WAVE_BYTES;
    const bf16_t* ar = A + (size_t)(32 * wave + (lane >> 3)) * K + (lane & 7) * 8;
    LAS unsigned char* wr = st + (lane >> 3) * SG_PITCH + (lane & 7) * 16;
    const LAS unsigned char* rd = st + fr * SG_PITCH + fq * 16;
    const bf16_t* bp[NT];
#pragma unroll
    for (int nt = 0; nt < NT; ++nt) { bp[nt] = Bt + (size_t)brow[nt] * K + fq * 8; acc[0][nt] = (f32x4){0.f, 0.f, 0.f, 0.f}; acc[1][nt] = (f32x4){0.f, 0.f, 0.f, 0.f}; }
    const int nks = K / 32;
#pragma unroll 1
    for (int k0 = 0; k0 < nks; k0 += 8) {
        bf16x8 al[4][4], bf[8][NT];
#pragma unroll
        for (int rg = 0; rg < 4; ++rg)
#pragma unroll
            for (int ln = 0; ln < 4; ++ln) al[rg][ln] = *(const bf16x8*)(ar + (size_t)(8 * rg) * K + k0 * 32 + ln * 64);
#pragma unroll
        for (int u = 0; u < 8; ++u)
#pragma unroll
            for (int nt = 0; nt < NT; ++nt) bf[u][nt] = *(const bf16x8*)(bp[nt] + (k0 + u) * 32);
#pragma unroll
        for (int rg = 0; rg < 4; ++rg)
#pragma unroll
            for (int ln = 0; ln < 4; ++ln) *(LAS bf16x8*)(wr + (8 * rg) * SG_PITCH + ln * 128) = al[rg][ln];
#pragma unroll
        for (int u = 0; u < 8; ++u) {
            const bf16x8 af0 = *(const LAS bf16x8*)(rd + u * 64), af1 = *(const LAS bf16x8*)(rd + 16 * SG_PITCH + u * 64);
#pragma unroll
            for (int nt = 0; nt < NT; ++nt) {
                acc[0][nt] = __builtin_amdgcn_mfma_f32_16x16x32_bf16(bf[u][nt], af0, acc[0][nt], 0, 0, 0); acc[1][nt] = __builtin_amdgcn_mfma_f32_16x16x32_bf16(bf[u][nt], af1, acc[1][nt], 0, 0, 0); }
        }
    }
}
template <int NT> __device__ __forceinline__ void sgemm1(LAS unsigned char* lds, const bf16_t* A, const bf16_t* Bt, int K, const int (&brow)[NT], int row0, int wave, int lane, f32x4 (&acc)[NT]) {
    const int fr = lane & 15, fq = lane >> 4;
    LAS unsigned char* st = lds + wave * SG_WAVE_BYTES;
    const bf16_t* ar = A + (size_t)(row0 + 16 * wave + (lane >> 3)) * K + (lane & 7) * 8;
    LAS unsigned char* wr = st + (lane >> 3) * SG_PITCH + (lane & 7) * 16;
    const LAS unsigned char* rd = st + fr * SG_PITCH + fq * 16;
    const bf16_t* bp[NT];
#pragma unroll
    for (int nt = 0; nt < NT; ++nt) { bp[nt] = Bt + (size_t)brow[nt] * K + fq * 8; acc[nt] = (f32x4){0.f, 0.f, 0.f, 0.f}; }
    const int nks = K / 32;
    bf16x8 al[2][4], bf[8][NT];
#define SG1_LOAD(AL, BF, K0) do { _Pragma("unroll") for (int rg_ = 0; rg_ < 2; ++rg_) _Pragma("unroll") for (int ln_ = 0; ln_ < 4; ++ln_) AL[rg_][ln_] = *(const bf16x8*)(ar + (size_t)(8 * rg_) * K + (K0) * 32 + ln_ * 64); \
        _Pragma("unroll") for (int u_ = 0; u_ < 8; ++u_) _Pragma("unroll") for (int nt_ = 0; nt_ < NT; ++nt_) BF[u_][nt_] = *(const bf16x8*)(bp[nt_] + ((K0) + u_) * 32); } while (0)
    SG1_LOAD(al, bf, 0);
#pragma unroll 1
    for (int k0 = 0; k0 < nks; k0 += 8) {
        bf16x8 nal[2][4], nbf[8][NT];
        { const int kn = k0 + 8 < nks ? k0 + 8 : k0; SG1_LOAD(nal, nbf, kn); }
#pragma unroll
        for (int rg = 0; rg < 2; ++rg)
#pragma unroll
            for (int ln = 0; ln < 4; ++ln) *(LAS bf16x8*)(wr + (8 * rg) * SG_PITCH + ln * 128) = al[rg][ln];
#pragma unroll
        for (int u = 0; u < 8; ++u) {
            const bf16x8 af0 = *(const LAS bf16x8*)(rd + u * 64);
#pragma unroll
            for (int nt = 0; nt < NT; ++nt) acc[nt] = __builtin_amdgcn_mfma_f32_16x16x32_bf16(bf[u][nt], af0, acc[nt], 0, 0, 0);
        }
#pragma unroll
        for (int rg = 0; rg < 2; ++rg)
#pragma unroll
            for (int ln = 0; ln < 4; ++ln) al[rg][ln] = nal[rg][ln];
#pragma unroll
        for (int u = 0; u < 8; ++u)
#pragma unroll
            for (int nt = 0; nt < NT; ++nt) bf[u][nt] = nbf[u][nt];
    }
#undef SG1_LOAD
}
template <bool PART> __device__ __forceinline__ void s_gu(LAS unsigned char* lds, const bf16_t* XBs, const bf16_t* Wgu, bf16_t* ACT, const float* ssq, int s, int wave, int lane) {
    const int fr = lane & 15, fq = lane >> 4;
    int j = 11 * s + fr; j = j > FF - 1 ? FF - 1 : j;
    int brow[2]; brow[0] = (j >> 7) * 256 + (j & 127); brow[1] = brow[0] + 128;
    f32x4 acc[2][2]; sgemm<2, 8>(lds, XBs, Wgu, DM, brow, wave, lane, acc);
#pragma unroll
    for (int mt = 0; mt < 2; ++mt) { const int r = NP + 32 * wave + 16 * mt + fr; const float rs = rstd_of(PART ? samp_ss(ssq, r - NP, fq) : ssq[r]);
#pragma unroll
        for (int e = 0; e < 4; ++e) if (4 * fq + e < 11) { const float g = acc[mt][0][e] * rs, up = acc[mt][1][e] * rs;
            ACT[(size_t)r * FF + 11 * s + 4 * fq + e] = (bf16_t)(pk2(silu_f(g) * up, 0.f) & 0xffffu); } }
}
template <bool BASE_F32, bool OUT_F32> __device__ __forceinline__ void s_res(LAS unsigned char* lds, const bf16_t* As, int K, const bf16_t* Wt, const float* base_s, float* X, bf16_t* XB, float* ssq, float scale, int s, int wave, int lane) {
    const int fr = lane & 15, fq = lane >> 4;
    const int rg = s & 1, cg = s >> 1;
    int brow[1]; brow[0] = 8 * cg + (fr < 7 ? fr : 7);
    f32x4 acc[1]; sgemm1<1>(lds, As, Wt, K, brow, 128 * rg, wave, lane, acc);
    const int rr = 128 * rg + 16 * wave + fr, r = NP + rr; const int col = 8 * cg + 4 * (fq & 1);
    float sq = 0.f;
    if (fq < 2) {
        f32x4 b;
        if (BASE_F32) b = *(const f32x4*)(base_s + (size_t)rr * DM + col);
        else { const u32x2 w = *(const u32x2*)(XB + (size_t)r * DM + col); b = (f32x4){bflo(w.x), bfhi(w.x), bflo(w.y), bfhi(w.y)}; }
        const f32x4 v = b + acc[0] * scale;
        if (OUT_F32) *(f32x4*)(X + (size_t)r * DM + col) = v;
        else { u32x2 w; w.x = pk2(v[0], v[1]); w.y = pk2(v[2], v[3]); *(u32x2*)(XB + (size_t)r * DM + col) = w; }
        sq = (v[0] * v[0] + v[1] * v[1]) + (v[2] * v[2] + v[3] * v[3]);
    }
    sq += __shfl_xor(sq, 16);
    if (fq == 0) ssq[(size_t)rr * 128 + cg] = sq;
}
__device__ __forceinline__ void s_cq(LAS unsigned char* lds, const bf16_t* XBs, const bf16_t* Wt, bf16_t* QX, const float* ssq, float scale, int s, int wave, int lane) {
    const int fr = lane & 15, fq = lane >> 4;
    const int rg = s & 1, cg = s >> 1;
    int brow[1]; brow[0] = 8 * cg + (fr < 7 ? fr : 7);
    f32x4 acc[1]; sgemm1<1>(lds, XBs, Wt, DM, brow, 128 * rg, wave, lane, acc);
    const int rr = 128 * rg + 16 * wave + fr, r = NP + rr;
    const float rs = rstd_of(samp_ss(ssq, rr, fq)) * scale;
    if (fq < 2) { const f32x4 v = acc[0] * rs; u32x2 w; w.x = pk2(v[0], v[1]); w.y = pk2(v[2], v[3]); *(u32x2*)(QX + (size_t)r * DM + 8 * cg + 4 * fq) = w; }
}
__device__ __forceinline__ void s_win(LAS unsigned char* lds, const bf16_t* XBs, const bf16_t* Win, bf16_t* QB, bf16_t* KB, bf16_t* VB, bf16_t* UB, float* out, const float* ssq, int s, int wave, int lane) {
    const int fr = lane & 15, fq = lane >> 4;
    int brow[3]; brow[0] = 6 * s + (fr < 5 ? fr : 5);
    { const int c = 2 * s + (fr < 1 ? fr : 1); brow[1] = 1536 + (c >> 7) * 256 + (c & 127); brow[2] = brow[1] + 128; }
    f32x4 acc[2][3]; sgemm<3, 8>(lds, XBs, Win, DM, brow, wave, lane, acc);
#pragma unroll
    for (int mt = 0; mt < 2; ++mt) { const int r = NP + 32 * wave + 16 * mt + fr; const int rr = r - NP; const float rs = rstd_of(samp_ss(ssq, rr, fq));
#pragma unroll
        for (int e = 0; e < 4; ++e) if (4 * fq + e < 6) { const int col = 6 * s + 4 * fq + e, sec = col >> 9, cc = col & 511; const float v = acc[mt][0][e] * rs;
            if (sec == 0) QB[(size_t)r * 512 + cc] = (bf16_t)(pk2(v * (0.125f * LOG2E), 0.f) & 0xffffu);
            else if (sec == 1) { out[O_WKS + (size_t)rr * 512 + cc] = v; KB[(size_t)r * 512 + cc] = (bf16_t)(pk2(v, 0.f) & 0xffffu); }
            else { out[O_WVS + (size_t)rr * 512 + cc] = v; VB[(size_t)r * 512 + cc] = (bf16_t)(pk2(v, 0.f) & 0xffffu); } }
        if (fq == 0) {
#pragma unroll
            for (int e = 0; e < 2; ++e) { const int c = 2 * s + e; const float uu = acc[mt][1][e] * rs * sigm_f(acc[mt][2][e] * rs);
                UB[(size_t)r * 512 + c] = (bf16_t)(pk2(uu, 0.f) & 0xffffu); out[O_CS + ((size_t)(rr >> 3) * 30 + 22 + (rr & 7)) * 512 + c] = uu; } }
    }
}

#define XB_TMO      128
#define XB_XCNT(j)  (256  + 64 * (j))
#define XB_XSUB(j)  (1280 + 64 * (j))
#define XB_XGEN(j)  (2304 + 64 * (j))
#define XB_TOP      3328
#define XB_TOPGEN   3392
#define XCD_BAR_WORDS 3456
#define XB_SPIN_CAP (1u << 18)

__device__ __forceinline__ unsigned xb_ld(unsigned* p)              { return __hip_atomic_load(p, __ATOMIC_RELAXED, __HIP_MEMORY_SCOPE_AGENT); }
__device__ __forceinline__ unsigned xb_add(unsigned* p, unsigned v) { return __hip_atomic_fetch_add(p, v, __ATOMIC_RELAXED, __HIP_MEMORY_SCOPE_AGENT); }
__device__ __forceinline__ unsigned xb_xcc_id() { return (unsigned)__builtin_amdgcn_s_getreg((3 << 11) | 20) & 0xFu; }
#define XB_SPIN(cond, bar) do { unsigned _sp = 0; while (cond) { __builtin_amdgcn_s_sleep(1); \
    if ((++_sp & 255u) == 0u) { if (xb_ld(&(bar)[XB_TMO])) break; if (_sp > XB_SPIN_CAP) { atomicAdd(&(bar)[XB_TMO], 1u); break; } } } } while (0)

struct XcdBarrier {
    unsigned* bar; unsigned x;
    volatile LAS unsigned* st;
};

__device__ __forceinline__ XcdBarrier xcd_barrier_post(unsigned* bar, volatile LAS unsigned* st) {
    XcdBarrier b; b.bar = bar; b.x = xb_xcc_id(); b.st = st;
    if (threadIdx.x == 0) (void)xb_add(&bar[XB_XCNT(b.x)], 1u);
    return b;
}
__device__ __forceinline__ void xcd_barrier_complete(unsigned* bar, unsigned x, unsigned& nloc, unsigned& nx) {
    const unsigned G = gridDim.x * gridDim.y * gridDim.z;
    unsigned sum, cnt, mine, sp = 0u;
    for (;;) {
        sum = 0u; cnt = 0u; mine = 0u;
#pragma unroll
        for (unsigned j = 0; j < 16; ++j) { const unsigned c = xb_ld(&bar[XB_XCNT(j)]); sum += c; cnt += (c > 0u) ? 1u : 0u; mine = (j == x) ? c : mine; }
        if (sum == G) break;
        __builtin_amdgcn_s_sleep(1);
        if ((++sp & 255u) == 0u) { if (xb_ld(&bar[XB_TMO])) break; if (sp > XB_SPIN_CAP) { atomicAdd(&bar[XB_TMO], 1u); break; } }
    }
    nloc = mine > 0u ? mine : 1u; nx = cnt > 0u ? cnt : 1u;
}

__device__ __forceinline__ void xcd_barrier(const XcdBarrier& b) {
    asm volatile("s_waitcnt vmcnt(0)" ::: "memory");
    __syncthreads();
    if (threadIdx.x == 0) {
        unsigned* bar = b.bar;
        __builtin_amdgcn_s_waitcnt(0);
        unsigned nloc = b.st[0], nx = b.st[1];
        if (nloc == 0u) { xcd_barrier_complete(bar, b.x, nloc, nx); b.st[0] = nloc; b.st[1] = nx; }
        const unsigned old = xb_add(&bar[XB_XSUB(b.x)], 1u);
        const unsigned gen = old / nloc;
        if (old + 1u == (gen + 1u) * nloc) {
            __builtin_amdgcn_fence(__ATOMIC_RELEASE, "agent");
            asm volatile("s_waitcnt vmcnt(0)" ::: "memory");
            const unsigned og = xb_add(&bar[XB_TOP], 1u);
            const unsigned tg = og / nx;
            if (og + 1u == (tg + 1u) * nx) xb_add(&bar[XB_TOPGEN], 1u);
            else XB_SPIN(xb_ld(&bar[XB_TOPGEN]) == tg, bar);
            __builtin_amdgcn_fence(__ATOMIC_ACQUIRE, "agent");
            xb_add(&bar[XB_XGEN(b.x)], 1u);
            asm volatile("s_waitcnt vmcnt(0)" ::: "memory");
        } else {
            XB_SPIN(xb_ld(&bar[XB_XGEN(b.x)]) == gen, bar);
            __builtin_amdgcn_fence(__ATOMIC_ACQUIRE, "agent");
            asm volatile("s_waitcnt vmcnt(0)" ::: "memory");
        }
    }
    __syncthreads();
}

#define GEMM_PHASE(EPI, A_, B_, M_, N_, K_, E_) do { pg8::Gemm g_{(const bf16_t*)(A_), (const bf16_t*)(B_), (M_), (N_), (K_)}; pg8::StaticOrder S_; S_.init((M_), (N_), G, (int)blockIdx.x); \
        pg8::gemm_phase<EPI, pg8::StaticOrder, true, true>(lds, g_, S_, (E_)); } while (0)

#ifndef REP_P0
#define REP_P0 1
#endif
#define STAGGER2(GEMM_STMT, SLICE_STMT) do { if (bx & 1) { for (int sl = bx; sl < 256; sl += G) { SLICE_STMT; } __syncthreads();   } GEMM_STMT; if (!(bx & 1)) { for (int sl = bx; sl < 256; sl += G) { SLICE_STMT; } } } while (0)
__global__ void __launch_bounds__(NTHREADS, 2) fwd_megakernel(Args args) {
    extern __shared__ __attribute__((aligned(16))) unsigned char lds_raw[];
    LAS unsigned char* lds = (LAS unsigned char*)lds_raw;
    const int tid = threadIdx.x, lane = tid & 63, wave = __builtin_amdgcn_readfirstlane(tid >> 6);
    const int G = gridDim.x, bx = blockIdx.x;
    unsigned char* ws = args.ws; float* out = args.out;
    float* ssq0 = (float*)(ws + WS_SSQ0); float* ssqm = (float*)(ws + WS_SSQM); float* ssqp = (float*)(ws + WS_SSQP); float* ssqs = (float*)(ws + WS_SSQS);
#define SSQP(k) (ssqp + (size_t)(k) * NP * 16)
#define SSQS(k) (ssqs + (size_t)(k) * 256 * 128)

    bf16_t* XB = (bf16_t*)(ws + WS_XB); bf16_t* MEMB = (bf16_t*)(ws + WS_MEMB); bf16_t* MKB = (bf16_t*)(ws + WS_MKB); bf16_t* MVB = (bf16_t*)(ws + WS_MVB);
    bf16_t* QB = (bf16_t*)(ws + WS_QB); bf16_t* KB = (bf16_t*)(ws + WS_KB); bf16_t* VB = (bf16_t*)(ws + WS_VB); bf16_t* UB = (bf16_t*)(ws + WS_UB);
    bf16_t* MIX = (bf16_t*)(ws + WS_MIX); bf16_t* QX = (bf16_t*)(ws + WS_QX); bf16_t* OX = (bf16_t*)(ws + WS_OX); bf16_t* ACT = (bf16_t*)(ws + WS_ACT);
    bf16_t* Wgu1 = (bf16_t*)(ws + WS_WGU1); bf16_t* Wd1 = (bf16_t*)(ws + WS_WD1); bf16_t* Win = (bf16_t*)(ws + WS_WIN); bf16_t* Wout = (bf16_t*)(ws + WS_WOUT);
    bf16_t* Wcq = (bf16_t*)(ws + WS_WCQ); bf16_t* Wckv = (bf16_t*)(ws + WS_WCKV); bf16_t* Wco = (bf16_t*)(ws + WS_WCO); bf16_t* Wgu2 = (bf16_t*)(ws + WS_WGU2); bf16_t* Wd2 = (bf16_t*)(ws + WS_WD2);
    const float* x_prompt = args.in[0]; const float* x_sample = args.in[1];
    float* X = out + O_Y;
    const int lo = args.ph_lo, hi = args.ph_hi;
    if (tid < 4) ((volatile LAS unsigned*)(lds + LDS_BYTES - 16))[tid] = 0u;
    __syncthreads();
    XcdBarrier xbar = xcd_barrier_post((unsigned*)(ws + WS_BAR), (volatile LAS unsigned*)(lds + LDS_BYTES - 16));
#ifndef SKIPMASK
#define SKIPMASK 0
#endif
#define IN(k) (!((SKIPMASK >> (k)) & 1) && lo <= (k) && (k) < hi)
#define SEAM(k) do { if (IN(k) && IN((k) + 1)) xcd_barrier(xbar); } while (0)

    if (IN(0)) {
        LAS float* scr = (LAS float*)(lds + wave * 16384);
        const int gw = bx * NWAVES + wave, NGW = G * NWAVES;
        constexpr int I_G = 16 * 88, I_D = 44 * 32, I_IN = 16 * 80, I_SQ = 16 * 32;
        constexpr int NITEMS = 6 * I_G + I_IN + 5 * I_SQ;
        for (int it = gw; it < NITEMS; it += NGW) {
            int r = it;
            if (r < I_G) { p0_transpose_item(args.in[9], DM, FF, Wgu1, 1, 0, args.in[8], scr, r, lane); continue; } r -= I_G;
            if (r < I_G) { p0_transpose_item(args.in[10], DM, FF, Wgu1, 2, 0, args.in[8], scr, r, lane); continue; } r -= I_G;
            if (r < I_D) { p0_transpose_item(args.in[11], FF, DM, Wd1, 0, 0, nullptr, scr, r, lane); continue; } r -= I_D;
            if (r < I_G) { p0_transpose_item(args.in[26], DM, FF, Wgu2, 1, 0, args.in[25], scr, r, lane); continue; } r -= I_G;
            if (r < I_G) { p0_transpose_item(args.in[27], DM, FF, Wgu2, 2, 0, args.in[25], scr, r, lane); continue; } r -= I_G;
            if (r < I_D) { p0_transpose_item(args.in[28], FF, DM, Wd2, 0, 0, nullptr, scr, r, lane); continue; } r -= I_D;
            if (r < I_IN) { p0_transpose_item(args.in[13], DM, 2560, Win, 3, 0, args.in[12], scr, r, lane); continue; } r -= I_IN;
            if (r < I_SQ) { p0_transpose_item(args.in[18], DM, DM, Wout, 0, 0, nullptr, scr, r, lane); continue; } r -= I_SQ;
            if (r < I_SQ) { p0_transpose_item(args.in[21], DM, DM, Wcq, 0, 0, args.in[19], scr, r, lane); continue; } r -= I_SQ;
            if (r < I_SQ) { p0_transpose_item(args.in[22], DM, DM, Wckv, 0, 0, args.in[20], scr, r, lane); continue; } r -= I_SQ;
            if (r < I_SQ) { p0_transpose_item(args.in[23], DM, DM, Wckv, 0, 1024, args.in[20], scr, r, lane); continue; } r -= I_SQ;
            p0_transpose_item(args.in[24], DM, DM, Wco, 0, 0, nullptr, scr, r, lane);
        }
        for (int m = gw; m < MT; m += 2 * NGW) {
            const int m1 = (m + NGW < MT) ? m + NGW : m;
            row2_to_bf16(m < NP ? x_prompt + (size_t)m * DM : x_sample + (size_t)(m - NP) * DM, m1 < NP ? x_prompt + (size_t)m1 * DM : x_sample + (size_t)(m1 - NP) * DM,
                         XB + (size_t)m * DM, XB + (size_t)m1 * DM, ssq0 + m, ssq0 + m1, lane);
        }
        for (int m = gw; m < NMEMROWS; m += NGW) row_to_bf16(args.in[2] + (size_t)m * DM, MEMB + (size_t)m * DM, ssqm + m, lane);
        for (int i = bx * NTHREADS + tid; i < 32 * 22 * 128; i += G * NTHREADS) { const int b = i / (22 * 128), rem = i - b * (22 * 128);
            *(f32x4*)(out + O_CS + (size_t)b * 30 * 512 + rem * 4) = *(const f32x4*)(args.in[5] + (size_t)b * 30 * 512 + 8 * 512 + rem * 4); }
    }
    SEAM(0);
    if (IN(1)) {
        { EpiGU<false> E{ACT, ssq0}; STAGGER2(GEMM_PHASE(EpiGU<false>, XB, Wgu1, NP, 2 * FF, DM, E), s_gu<false>(lds, XB + (size_t)NP * DM, Wgu1, ACT, ssq0, sl, wave, lane)); }
        __syncthreads();
        { EpiMemKV E{MKB, MVB, out, ssqm}; GEMM_PHASE(EpiMemKV, MEMB, Wckv, NMEMROWS, 2048, DM, E); }
    }
    SEAM(1);
    if (IN(2)) { typedef EpiRes<true, false> ER; ER E{x_prompt, X, XB, SSQP(0), 0.5f};
        STAGGER2(GEMM_PHASE(ER, ACT, Wd1, NP, DM, FF, E), (s_res<true, false>(lds, ACT + (size_t)NP * FF, FF, Wd1, x_sample, X, XB, SSQS(0), 0.5f, sl, wave, lane))); }
    SEAM(2);
    if (IN(3)) { EpiWin E{QB, KB, VB, UB, out, SSQP(0)}; STAGGER2(GEMM_PHASE(EpiWin, XB, Win, NP, 2560, DM, E), s_win(lds, XB + (size_t)NP * DM, Win, QB, KB, VB, UB, out, SSQS(0), sl, wave, lane)); }
    SEAM(3);
    if (IN(4)) {
#ifndef REP_AP
#define REP_AP 1
#endif
#ifndef REP_AS
#define REP_AS 1
#endif
#ifndef REP_CV
#define REP_CV 1
#endif
#ifndef REP_XA
#define REP_XA 1
#endif
#ifndef REP_P0
#define REP_P0 1
#endif
#ifndef NO_ATTNP
        for (int rep = 0; rep < REP_AP; ++rep)
        for (int u = bx; u < 1024; u += G) {
            const int xcd = u & 7, j = u >> 3; const int b = xcd * 2 + (j >> 6), jj = j & 63, h = jj & 7, blk = jj >> 3;
            attn_prompt_unit(lds, QB, KB, VB, MIX, b, h, blk, wave, lane);
        }
#endif
#ifndef NO_ATTNS
        for (int rep = 0; rep < REP_AS; ++rep)
        for (int u = bx; u < 256; u += G) attn_sample_unit(lds, QB, args.in[3], args.in[4], out, MIX, u >> 3, u & 7, wave, lane);
#endif
        __syncthreads();
#ifndef NO_CONV
        for (int rep = 0; rep < REP_CV; ++rep)
        for (int u = bx; u < 512 + 32; u += G) {
            if (u < 512) conv_unit(lds, 0, u >> 5, (u & 31) * 64, UB, args.in[5], args.in[14], args.in[15], args.in[16], args.in[17], MIX, tid, wave, lane);
            else conv_unit(lds, 1, u - 512, 0, UB, args.in[5], args.in[14], args.in[15], args.in[16], args.in[17], MIX, tid, wave, lane);
        }
#endif
    }
    SEAM(4);
    if (IN(5)) { typedef EpiRes<false, false> ER; ER E{nullptr, X, XB, SSQP(1), 1.0f};
        STAGGER2(GEMM_PHASE(ER, MIX, Wout, NP, DM, DM, E), (s_res<false, false>(lds, MIX + (size_t)NP * DM, DM, Wout, nullptr, X, XB, SSQS(1), 1.0f, sl, wave, lane))); }
    SEAM(5);
    if (IN(6)) { EpiCQ E{QX, SSQP(1), 0.0625f * LOG2E}; STAGGER2(GEMM_PHASE(EpiCQ, XB, Wcq, NP, DM, DM, E), s_cq(lds, XB + (size_t)NP * DM, Wcq, QX, SSQS(1), 0.0625f * LOG2E, sl, wave, lane)); }
    SEAM(6);
    if (IN(7)) {
        for (int rep = 0; rep < REP_XA; ++rep)
        for (int u = bx; u < 1024 + 128; u += G) {
            if (u < 1024) { const int h = u & 3, qb = u >> 2; const int b = qb >> 4;
                xattn_unit(lds, MKB + (size_t)b * 256 * DM + h * 256, MVB + (size_t)b * 256 * DM + h * 256, false, DM, QX, OX, qb * 128, 128, h, tid, wave, lane); }
            else { const int v = u - 1024, b = v >> 2, h = v & 3;
                xattn_unit(lds, args.in[6] + ((size_t)b * 256 * 4 + h) * 256, args.in[7] + ((size_t)b * 256 * 4 + h) * 256, true, DM, QX, OX, NP + b * 8, 8, h, tid, wave, lane); }
        }
    }
    SEAM(7);
    if (IN(8)) { typedef EpiRes<false, false> ER; ER E{nullptr, X, XB, SSQP(2), 1.0f};
        STAGGER2(GEMM_PHASE(ER, OX, Wco, NP, DM, DM, E), (s_res<false, false>(lds, OX + (size_t)NP * DM, DM, Wco, nullptr, X, XB, SSQS(2), 1.0f, sl, wave, lane))); }
    SEAM(8);
    if (IN(9)) { EpiGU<true> E{ACT, SSQP(2)}; STAGGER2(GEMM_PHASE(EpiGU<true>, XB, Wgu2, NP, 2 * FF, DM, E), s_gu<true>(lds, XB + (size_t)NP * DM, Wgu2, ACT, SSQS(2), sl, wave, lane)); }
    SEAM(9);
    if (IN(10)) { typedef EpiRes<false, false> ER; ER E{nullptr, X, XB, SSQP(3), 0.5f};
        STAGGER2(GEMM_PHASE(ER, ACT, Wd2, NP, DM, FF, E), (s_res<false, false>(lds, ACT + (size_t)NP * FF, FF, Wd2, nullptr, X, XB, SSQS(3), 0.5f, sl, wave, lane))); }
    SEAM(10);
    if (IN(11)) {
        const int gw = bx * NWAVES + wave, NGW = G * NWAVES;
        const float* gf = args.in[29];
        f32x4 gg[4];
#pragma unroll
        for (int j = 0; j < 4; ++j) gg[j] = ((const f32x4*)gf)[lane + 64 * j];
        for (int m = gw; m < MT; m += 2 * NGW) {
            const int m1 = (m + NGW < MT) ? m + NGW : m;
            float ss0, ss1;
            if (m < NP) ss0 = rowss<true>(SSQP(3), m); else { const f32x2 t = ((const f32x2*)(SSQS(3) + (size_t)(m - NP) * 128))[lane]; ss0 = wave_sum(t[0] + t[1]); }
            if (m1 < NP) ss1 = rowss<true>(SSQP(3), m1); else { const f32x2 t = ((const f32x2*)(SSQS(3) + (size_t)(m1 - NP) * 128))[lane]; ss1 = wave_sum(t[0] + t[1]); }
            const float rs0 = rstd_of(ss0), rs1 = rstd_of(ss1);
            f32x4* xr0 = (f32x4*)(X + (size_t)m * DM) + lane; f32x4* xr1 = (f32x4*)(X + (size_t)m1 * DM) + lane;
            const u32x2* br0 = (const u32x2*)(XB + (size_t)m * DM) + lane; const u32x2* br1 = (const u32x2*)(XB + (size_t)m1 * DM) + lane;
            u32x2 w0[4], w1[4];
#pragma unroll
            for (int j = 0; j < 4; ++j) { w0[j] = br0[64 * j]; w1[j] = br1[64 * j]; }
#pragma unroll
            for (int j = 0; j < 4; ++j) {
                const f32x4 v0 = (f32x4){bflo(w0[j].x), bfhi(w0[j].x), bflo(w0[j].y), bfhi(w0[j].y)}, v1 = (f32x4){bflo(w1[j].x), bfhi(w1[j].x), bflo(w1[j].y), bfhi(w1[j].y)};
                __builtin_nontemporal_store(v0 * rs0 * gg[j], xr0 + 64 * j); if (m1 != m) __builtin_nontemporal_store(v1 * rs1 * gg[j], xr1 + 64 * j); }
        }
    }
#undef IN
#undef SEAM
}

#ifndef MK_N_LAUNCHES
#define MK_N_LAUNCHES 1
#endif
extern "C" void kernel_launch(void* const* d_in, const int* in_sizes, int n_in, void* d_out, int out_size, void* d_ws, size_t ws_size, hipStream_t stream) {
    static int grid = 0;
    if (grid == 0) {
        if (n_in != 30 || (size_t)out_size != O_END || ws_size < WS_END) { fprintf(stderr, "kernel_launch: unexpected sizes: n_in %d out %d ws %zu\n", n_in, out_size, ws_size); grid = -1; return; }
        int dev = 0, cus = 0, per_cu = 0;
        hipGetDevice(&dev); hipDeviceGetAttribute(&cus, hipDeviceAttributeMultiprocessorCount, dev);
        if (hipFuncSetAttribute((const void*)fwd_megakernel, hipFuncAttributeMaxDynamicSharedMemorySize, LDS_BYTES) != hipSuccess) { fprintf(stderr, "kernel_launch: hipFuncSetAttribute failed\n"); grid = -1; return; }
        if (hipOccupancyMaxActiveBlocksPerMultiprocessor(&per_cu, (const void*)fwd_megakernel, NTHREADS, LDS_BYTES) != hipSuccess || per_cu < 1) { fprintf(stderr, "kernel_launch: occupancy query says %d blocks per CU\n", per_cu); grid = -1; (void)hipGetLastError(); return; }
        grid = cus;
        if (grid > 256) grid = 256;
    }
    if (grid < 0) return;
    Args a{};
    for (int i = 0; i < 30; ++i) a.in[i] = (const float*)d_in[i];
    a.out = (float*)d_out; a.ws = (unsigned char*)d_ws;
#if MK_N_LAUNCHES == 1
    a.ph_lo = 0; a.ph_hi = 12;
    if (hipMemsetAsync((char*)d_ws + WS_BAR, 0, XCD_BAR_WORDS * sizeof(unsigned), stream) != hipSuccess) { fprintf(stderr, "kernel_launch: hipMemsetAsync of the barrier words failed; nothing launched\n"); return; }
    hipLaunchKernelGGL(fwd_megakernel, dim3(grid), dim3(NTHREADS), LDS_BYTES, stream, a);
    const hipError_t e = hipPeekAtLastError();
    if (e != hipSuccess) fprintf(stderr, "kernel_launch: launch failed: %s (grid %d)\n", hipGetErrorString(e), grid);
#else
    for (int p = 0; p < 12; ++p) { a.ph_lo = p; a.ph_hi = p + 1; hipLaunchKernelGGL(fwd_megakernel, dim3(grid), dim3(NTHREADS), LDS_BYTES, stream, a); }
#endif
}
```

```cpp
#include <hip/hip_runtime.h>
#include <cstdio>
#include <cstdint>
namespace pg8 {
#define PG8_LAS __attribute__((address_space(3)))
typedef unsigned short bf16_t;
typedef short bf16x8 __attribute__((ext_vector_type(8)));
typedef float f32x4 __attribute__((ext_vector_type(4)));
typedef unsigned u32x4 __attribute__((ext_vector_type(4)));
constexpr int BM = 256, BK = 64, HALF = 128, HTB = HALF * BK * 2  , STAGE_BYTES = 8 * HTB, NXCD = 8, WGM = 8;

__host__ __device__ __forceinline__ int lds_byte(int r, int c) { const int st = (r >> 4) * 2 + (c >> 5), rr = r & 15, cc = c & 31, ob = rr * 64 + cc * 2; return st * 1024 + (ob ^ (((ob >> 9) & 1) << 5)); }
__host__ __device__ __forceinline__ void stage_rc(int b, int& R, int& C) { const int st = b / 1024, sb = b % 1024, swz = sb ^ (((sb >> 9) & 1) << 5); R = (st >> 1) * 16 + swz / 64; C = (st & 1) * 32 + (swz % 64) / 2; }
__host__ __device__ __forceinline__ int perm32(int rho) { const int n = rho >> 4, i = rho & 15; return 8 * (i >> 2) + 4 * n + (i & 3); }

struct Unit { int pm, pn; };
struct Gemm { const bf16_t* A; const bf16_t* Bt; int M, N, K; };

struct StaticOrder {
    int nM, nN, nwg, G, c;
    __host__ __device__ void init(int M, int N, int G_, int c_) { nM = M / BM; nN = N / BM; nwg = nM * nN; G = G_; c = c_; }
    __host__ __device__ bool next(int i, Unit& u) const {
        const long L = (long)i * G + c; if (L >= nwg) return false;
        int wgid = (int)L; { const int q = nwg / NXCD, r = nwg % NXCD, xcd = wgid % NXCD, off = wgid / NXCD; wgid = (xcd < r ? xcd * (q + 1) : r * (q + 1) + (xcd - r) * q) + off; }
        const int nig = WGM * nN, gid = wgid / nig, fm = gid * WGM, gsz = (nM - fm) < WGM ? (nM - fm) : WGM;
        u.pm = fm + ((wgid % nig) % gsz); u.pn = (wgid % nig) / gsz; return true;
    }
    __device__ __forceinline__ void a_ready(const Unit&) const {}
    __device__ __forceinline__ void done(const Unit&) const {}
};

__device__ __forceinline__ unsigned cvt_pk_bf16(float lo, float hi) { unsigned r; asm volatile("v_cvt_pk_bf16_f32 %0, %1, %2" : "=v"(r) : "v"(lo), "v"(hi)); return r; }
template <class Epi, class Sched, bool ALIGN_EPI = false, bool SP2 = false>
__device__ __forceinline__ void gemm_phase(PG8_LAS unsigned char* lds, const Gemm g, const Sched& S, const Epi& E) {
    const int tid = threadIdx.x, wid = __builtin_amdgcn_readfirstlane(tid >> 6), lane = tid & 63, wr = wid >> 2, wc = wid & 3, fr = lane & 15, fq = lane >> 4;
    const int K = g.K, nt = K / BK;
    unsigned voffA[2], voffB[2];
#pragma unroll
    for (int i = 0; i < 2; ++i) { int R, C; stage_rc(tid * 16 + i * 8192, R, C); const int Rb = Epi::PERM ? ((R & ~31) + perm32(R & 31)) : R;
        voffA[i] = (unsigned)(R * K + C) * 2u; voffB[i] = (unsigned)(Rb * K + C) * 2u; }
    const size_t kstep = (size_t)(BK * 2);
    const size_t hstep = (size_t)HALF * K * 2;
    const size_t tstep = 2 * hstep;
    const unsigned ldsw = (unsigned)wid * 1024u;
    const int aoff = lds_byte(wr * 64 + fr, fq * 8), boff = lds_byte(wc * 32 + fr, fq * 8);
#define PG8_SA(b, h) (((b) * 2 + (h)) * HTB)
#define PG8_SB(b, h) ((4 + (b) * 2 + (h)) * HTB)
#define PG8_STAGE(bufoff, gbase, voff) do { _Pragma("unroll") for (int _i = 0; _i < 2; ++_i) \
        __builtin_amdgcn_global_load_lds((const unsigned*)((const char*)(gbase) + (voff)[_i]), (PG8_LAS unsigned*)(lds + (bufoff) + ldsw + _i * 8192), 16, 0, 0); } while (0)
#define PG8_LDA(dst, b, h) do { _Pragma("unroll") for (int m = 0; m < 4; ++m) _Pragma("unroll") for (int k = 0; k < 2; ++k) dst[m][k] = *(const PG8_LAS bf16x8*)(lds + PG8_SA(b, h) + aoff + m * 2048 + k * 1024); } while (0)
#define PG8_LDB(dst, b, h) do { _Pragma("unroll") for (int n = 0; n < 2; ++n) _Pragma("unroll") for (int k = 0; k < 2; ++k) dst[n][k] = *(const PG8_LAS bf16x8*)(lds + PG8_SB(b, h) + boff + n * 2048 + k * 1024); } while (0)
#define PG8_MMA(ai, bj, At, Bt) do { __builtin_amdgcn_s_setprio(1); _Pragma("unroll") for (int m = 0; m < 4; ++m) _Pragma("unroll") for (int n = 0; n < 2; ++n) _Pragma("unroll") for (int k = 0; k < 2; ++k) \
        acc[ai][bj][m][n] = __builtin_amdgcn_mfma_f32_16x16x32_bf16(Bt[n][k], At[m][k], acc[ai][bj][m][n], 0, 0, 0); __builtin_amdgcn_s_setprio(0); } while (0)
#define PG8_WAIT_V(n) asm volatile("s_waitcnt vmcnt(" #n ")" ::: "memory")
#define PG8_WAIT_L(n) asm volatile("s_waitcnt lgkmcnt(" #n ")" ::: "memory")
#define PG8_BAR __builtin_amdgcn_s_barrier()
#define PG8_SCHED __builtin_amdgcn_sched_barrier(0)
    Unit cur, nxt; int ui = 0;
    if (!S.next(0, cur)) return;
    f32x4 acc[2][2][4][2];
#pragma unroll
    for (int a = 0; a < 2; ++a)
#pragma unroll
        for (int b = 0; b < 2; ++b)
#pragma unroll
            for (int m = 0; m < 4; ++m)
#pragma unroll
                for (int n = 0; n < 2; ++n) acc[a][b][m][n] = (f32x4){0.f, 0.f, 0.f, 0.f};
    bf16x8 At[4][2], B0[2][2], B1[2][2];
    const char* cA = (const char*)g.A + (size_t)cur.pm * tstep; const char* cB = (const char*)g.Bt + (size_t)cur.pn * tstep;
    S.a_ready(cur);
    if constexpr (SP2) {
        PG8_STAGE(PG8_SB(0, 0), cB, voffB); PG8_STAGE(PG8_SB(0, 1), cB + hstep, voffB); PG8_STAGE(PG8_SA(0, 0), cA, voffA); PG8_STAGE(PG8_SA(0, 1), cA + hstep, voffA);
        if (wr == 1) PG8_BAR;
        PG8_WAIT_V(2); PG8_BAR;
        PG8_STAGE(PG8_SB(1, 0), cB + kstep, voffB); PG8_STAGE(PG8_SA(1, 0), cA + kstep, voffA); PG8_STAGE(PG8_SB(1, 1), cB + hstep + kstep, voffB);
        PG8_WAIT_V(6); PG8_BAR;
    } else {
        PG8_STAGE(PG8_SB(0, 0), cB, voffB); PG8_STAGE(PG8_SA(0, 0), cA, voffA); PG8_STAGE(PG8_SB(0, 1), cB + hstep, voffB); PG8_STAGE(PG8_SA(0, 1), cA + hstep, voffA);
        if (wr == 1) PG8_BAR;
        PG8_WAIT_V(4); PG8_BAR;
        PG8_STAGE(PG8_SB(1, 0), cB + kstep, voffB); PG8_STAGE(PG8_SA(1, 0), cA + kstep, voffA); PG8_STAGE(PG8_SB(1, 1), cB + hstep + kstep, voffB);
        PG8_WAIT_V(6); PG8_BAR;
    }
    for (;;) {
        const bool has_next = S.next(ui + 1, nxt);
        const char* nA = has_next ? (const char*)g.A + (size_t)nxt.pm * tstep : cA; const char* nB = has_next ? (const char*)g.Bt + (size_t)nxt.pn * tstep : cB;
        for (int t = 0; t < nt; t += 2) {
            const bool last = (t == nt - 2);
            const char* a1 = cA + (size_t)(t + 1) * kstep;
            const char* a2 = last ? nA : cA + (size_t)(t + 2) * kstep; const char* b2 = last ? nB : cB + (size_t)(t + 2) * kstep;
            const char* a3 = a2 + kstep; const char* b3 = b2 + kstep;
            if (last && has_next) S.a_ready(nxt);
            if constexpr (SP2) {
            PG8_LDB(B0, 0, 0); PG8_LDB(B1, 0, 1); PG8_SCHED; PG8_LDA(At, 0, 0); PG8_STAGE(PG8_SA(1, 1), a1 + hstep, voffA);
            PG8_WAIT_V(8); PG8_WAIT_L(0); PG8_BAR; PG8_MMA(0, 0, At, B0); PG8_MMA(0, 1, At, B1); PG8_BAR; PG8_SCHED;
            PG8_LDA(At, 0, 1); PG8_STAGE(PG8_SB(0, 0), b2, voffB); PG8_STAGE(PG8_SB(0, 1), b2 + hstep, voffB); PG8_STAGE(PG8_SA(0, 0), a2, voffA);
            PG8_WAIT_V(8); PG8_WAIT_L(0); PG8_BAR; PG8_MMA(1, 0, At, B0); PG8_MMA(1, 1, At, B1); PG8_BAR; PG8_SCHED;
            PG8_LDB(B0, 1, 0); PG8_LDB(B1, 1, 1); PG8_SCHED; PG8_LDA(At, 1, 0); PG8_STAGE(PG8_SA(0, 1), a2 + hstep, voffA);
            PG8_WAIT_V(8); PG8_WAIT_L(0); PG8_BAR; PG8_MMA(0, 0, At, B0); PG8_MMA(0, 1, At, B1); PG8_BAR; PG8_SCHED;
            PG8_LDA(At, 1, 1); PG8_STAGE(PG8_SB(1, 0), b3, voffB); PG8_STAGE(PG8_SB(1, 1), b3 + hstep, voffB); PG8_STAGE(PG8_SA(1, 0), a3, voffA);
            PG8_WAIT_V(8); PG8_WAIT_L(0); PG8_BAR; PG8_MMA(1, 0, At, B0); PG8_MMA(1, 1, At, B1); PG8_BAR; PG8_SCHED;
            } else {
            PG8_LDB(B0, 0, 0); PG8_SCHED; PG8_LDA(At, 0, 0); PG8_STAGE(PG8_SA(1, 1), a1 + hstep, voffA);
            PG8_WAIT_L(8); PG8_BAR; PG8_WAIT_L(0); PG8_MMA(0, 0, At, B0); PG8_BAR; PG8_SCHED;
            PG8_LDB(B1, 0, 1); PG8_STAGE(PG8_SB(0, 0), b2, voffB);
            PG8_BAR; PG8_WAIT_L(0); PG8_MMA(0, 1, At, B1); PG8_BAR;
            PG8_LDA(At, 0, 1); PG8_STAGE(PG8_SA(0, 0), a2, voffA);
            PG8_BAR; PG8_WAIT_L(0); PG8_MMA(1, 0, At, B0); PG8_BAR; PG8_SCHED;
            PG8_STAGE(PG8_SB(0, 1), b2 + hstep, voffB);
            PG8_WAIT_V(6); PG8_BAR; PG8_MMA(1, 1, At, B1); PG8_BAR;
            PG8_LDB(B0, 1, 0); PG8_SCHED; PG8_LDA(At, 1, 0); PG8_STAGE(PG8_SA(0, 1), a2 + hstep, voffA);
            PG8_WAIT_L(8); PG8_BAR; PG8_WAIT_L(0); PG8_MMA(0, 0, At, B0); PG8_BAR; PG8_SCHED;
            PG8_LDB(B1, 1, 1); PG8_STAGE(PG8_SB(1, 0), b3, voffB);
            PG8_BAR; PG8_WAIT_L(0); PG8_MMA(0, 1, At, B1); PG8_BAR;
            PG8_LDA(At, 1, 1); PG8_STAGE(PG8_SA(1, 0), a3, voffA);
            PG8_BAR; PG8_WAIT_L(0); PG8_MMA(1, 0, At, B0); PG8_BAR; PG8_SCHED;
            PG8_STAGE(PG8_SB(1, 1), b3 + hstep, voffB);
            PG8_WAIT_V(6); PG8_BAR; PG8_MMA(1, 1, At, B1); PG8_BAR;
            }
        }
        if constexpr (ALIGN_EPI) { if (wr == 0) PG8_BAR; }
        if constexpr (!Epi::AFTER_DRAIN) { E(acc, cur, wr, wc, fr, fq); S.done(cur); }
        if (!has_next) break;
#pragma unroll
        for (int a = 0; a < 2; ++a)
#pragma unroll
            for (int b = 0; b < 2; ++b)
#pragma unroll
                for (int m = 0; m < 4; ++m)
#pragma unroll
                    for (int n = 0; n < 2; ++n) acc[a][b][m][n] = (f32x4){0.f, 0.f, 0.f, 0.f};
        cur = nxt; cA = nA; cB = nB; ++ui;
        if constexpr (ALIGN_EPI) { if (wr == 1) PG8_BAR; }
    }
    PG8_WAIT_V(0);
    if constexpr (!ALIGN_EPI) { if (wr == 0) PG8_BAR; }
    PG8_BAR;
    if constexpr (Epi::AFTER_DRAIN) { E.fused(acc, cur, wr, wc, fr, fq, lds, wid, lane); S.done(cur); }
#undef PG8_SA
#undef PG8_SB
#undef PG8_STAGE
#undef PG8_LDA
#undef PG8_LDB
#undef PG8_MMA
#undef PG8_WAIT_V
#undef PG8_WAIT_L
#undef PG8_BAR
#undef PG8_SCHED
}
}

#define LAS __attribute__((address_space(3)))
typedef unsigned short bf16_t;
typedef short bf16x8 __attribute__((ext_vector_type(8)));
typedef short s16x4 __attribute__((ext_vector_type(4)));
typedef float f32x4 __attribute__((ext_vector_type(4)));
typedef float f32x2 __attribute__((ext_vector_type(2)));
typedef unsigned u32x4 __attribute__((ext_vector_type(4)));
typedef unsigned u32x2 __attribute__((ext_vector_type(2)));

constexpr int DM = 1024, NP = 32768, NS = 256, MT = NP + NS, SEQ = 2048, FF = 2816, NMEMROWS = 4096;
constexpr float EPS = 1e-6f, LOG2E = 1.4426950408889634f;
constexpr int NWAVES = 8, NTHREADS = 512;
constexpr int LDS_BYTES = 147456;
constexpr size_t O_Y = 0, O_YS = 33554432, O_WKP = 33816576, O_WVP = 50593792, O_CP = 67371008, O_MKP = 67616768, O_MVP = 71811072,
                 O_WKS = 76005376, O_WVS = 76136448, O_CS = 76267520, O_END = 76759040;
constexpr size_t MiB = 1u << 20;
constexpr size_t WS_SSQ0 = 0, WS_SSQM = 256 * 1024, WS_SSQ = 512 * 1024;
constexpr size_t WS_BAR = 1536 * 1024;
constexpr size_t WS_WGU1 = 2 * MiB, WS_WD1 = 14 * MiB, WS_WIN = 20 * MiB, WS_WOUT = 26 * MiB, WS_WCQ = 28 * MiB, WS_WCKV = 30 * MiB, WS_WCO = 34 * MiB,
                 WS_WGU2 = 36 * MiB, WS_WD2 = 48 * MiB;
constexpr size_t WS_XB = 56 * MiB, WS_MEMB = 122 * MiB, WS_MKB = 130 * MiB, WS_MVB = 138 * MiB;
constexpr size_t WS_QB = 148 * MiB, WS_KB = 181 * MiB, WS_VB = 214 * MiB, WS_UB = 247 * MiB, WS_MIX = 280 * MiB, WS_QX = 345 * MiB, WS_OX = 410 * MiB, WS_END = 485 * MiB;
static_assert(WS_VB - WS_KB == WS_KB - WS_QB, "QB|KB|VB spacing");
constexpr size_t WS_SSQP = 476 * MiB, WS_SSQS = 484 * MiB;
constexpr size_t WS_ACT = 148 * MiB;

struct Args { const float* in[30]; float* out; unsigned char* ws; int ph_lo, ph_hi; };

__device__ __forceinline__ unsigned pk2(float lo, float hi) { return pg8::cvt_pk_bf16(lo, hi); }
__device__ __forceinline__ float bflo(unsigned u) { return __uint_as_float(u << 16); }
__device__ __forceinline__ float bfhi(unsigned u) { return __uint_as_float(u & 0xffff0000u); }
__device__ __forceinline__ float fexp2(float x) { return __builtin_amdgcn_exp2f(x); }
__device__ __forceinline__ float frcp(float x) { return __builtin_amdgcn_rcpf(x); }
__device__ __forceinline__ float silu_f(float x) { return x * frcp(1.0f + fexp2(-x * LOG2E)); }
__device__ __forceinline__ float sigm_f(float x) { return frcp(1.0f + fexp2(-x * LOG2E)); }
__device__ __forceinline__ float wave_sum(float v) {
#pragma unroll
    for (int o = 1; o < 64; o <<= 1) v += __shfl_xor(v, o);
    return v;
}
__device__ __forceinline__ float rstd_of(float ssq) { return __builtin_amdgcn_rsqf(ssq * (1.0f / 1024.0f) + EPS); }

template <bool PART> __device__ __forceinline__ float rowss4(const float* p, int row, int fq) {
    if (!PART) return p[row];
    const f32x4 a = ((const f32x4*)(p + (size_t)row * 16))[fq];
    float v = (a[0] + a[1]) + (a[2] + a[3]);
    v += __shfl_xor(v, 16); v += __shfl_xor(v, 32);
    return v;
}
template <bool PART> __device__ __forceinline__ float rowss(const float* p, int row) {
    if (!PART) return p[row];
    const f32x4* q = (const f32x4*)(p + (size_t)row * 16); const f32x4 a = q[0], b = q[1], c = q[2], d = q[3];
    return ((a[0] + a[1]) + (a[2] + a[3])) + ((b[0] + b[1]) + (b[2] + b[3])) + ((c[0] + c[1]) + (c[2] + c[3])) + ((d[0] + d[1]) + (d[2] + d[3]));
}
__device__ __forceinline__ float samp_ss(const float* ps, int rr, int fq) {
    const f32x4* q = (const f32x4*)(ps + (size_t)rr * 128 + fq * 32); f32x4 t = (f32x4){0.f, 0.f, 0.f, 0.f};
#pragma unroll
    for (int i = 0; i < 8; ++i) t = t + q[i];
    float v = (t[0] + t[1]) + (t[2] + t[3]);
    v += __shfl_xor(v, 16); v += __shfl_xor(v, 32);
    return v;
}
using pg8::Unit;
template <bool PART> struct EpiGU {
    static constexpr bool PERM = true, AFTER_DRAIN = false;
    bf16_t* ACT; const float* ssq;
    __device__ __forceinline__ void operator()(const f32x4 (&acc)[2][2][4][2], const Unit& u, int wr, int wc, int fr, int fq) const {
        const int row0 = u.pm * 256 + wr * 64 + fr; const int col0 = u.pn * 128 + wc * 32 + 8 * fq;
        float rsv[8];
#pragma unroll
        for (int i = 0; i < 8; ++i) rsv[i] = rowss4<PART>(ssq, row0 + (i >> 2) * 128 + (i & 3) * 16, fq);
#pragma unroll
        for (int ai = 0; ai < 2; ++ai)
#pragma unroll
            for (int m = 0; m < 4; ++m) {
                const int row = row0 + ai * 128 + m * 16; const float rs = rstd_of(rsv[ai * 4 + m]);
                float v[8];
#pragma unroll
                for (int n = 0; n < 2; ++n)
#pragma unroll
                    for (int e = 0; e < 4; ++e) { const float g = acc[ai][0][m][n][e] * rs, up = acc[ai][1][m][n][e] * rs; v[n * 4 + e] = silu_f(g) * up; }
                u32x4 w; w.x = pk2(v[0], v[1]); w.y = pk2(v[2], v[3]); w.z = pk2(v[4], v[5]); w.w = pk2(v[6], v[7]);
                *(u32x4*)(ACT + (size_t)row * FF + col0) = w;
            }
    }
};
template <bool BASE_F32, bool OUT_F32> struct EpiRes {
    static constexpr bool PERM = true, AFTER_DRAIN = false;
    const float* base_p; float* X; bf16_t* XB; float* ssq; float scale;
    __device__ __forceinline__ void operator()(const f32x4 (&acc)[2][2][4][2], const Unit& u, int wr, int wc, int fr, int fq) const {
        const int row0 = u.pm * 256 + wr * 64 + fr; const int col0 = u.pn * 256 + wc * 32 + 8 * fq;
#pragma unroll
        for (int ai = 0; ai < 2; ++ai) {
            f32x4 pre[4][2][2];
#pragma unroll
            for (int m = 0; m < 4; ++m)
#pragma unroll
                for (int bj = 0; bj < 2; ++bj) {
                    const size_t off = (size_t)(row0 + ai * 128 + m * 16) * DM + col0 + bj * 128;
                    if (BASE_F32) { pre[m][bj][0] = __builtin_nontemporal_load((const f32x4*)(base_p + off)); pre[m][bj][1] = __builtin_nontemporal_load((const f32x4*)(base_p + off + 4)); }
                    else { const u32x4 w = *(const u32x4*)(XB + off); pre[m][bj][0] = (f32x4){bflo(w.x), bfhi(w.x), bflo(w.y), bfhi(w.y)}; pre[m][bj][1] = (f32x4){bflo(w.z), bfhi(w.z), bflo(w.w), bfhi(w.w)}; }
                }
            asm volatile("" ::: "memory");
#pragma unroll
            for (int m = 0; m < 4; ++m) {
                const int row = row0 + ai * 128 + m * 16;
                float sq = 0.f;
#pragma unroll
                for (int bj = 0; bj < 2; ++bj) {
                    const size_t off = (size_t)row * DM + col0 + bj * 128;
                    const f32x4 v0 = pre[m][bj][0] + acc[ai][bj][m][0] * scale, v1 = pre[m][bj][1] + acc[ai][bj][m][1] * scale;
                    if (OUT_F32) { *(f32x4*)(X + off) = v0; *(f32x4*)(X + off + 4) = v1; }
                    else { u32x4 w; w.x = pk2(v0[0], v0[1]); w.y = pk2(v0[2], v0[3]); w.z = pk2(v1[0], v1[1]); w.w = pk2(v1[2], v1[3]); *(u32x4*)(XB + off) = w; }
                    sq += ((v0[0] * v0[0] + v0[1] * v0[1]) + (v0[2] * v0[2] + v0[3] * v0[3])) + ((v1[0] * v1[0] + v1[1] * v1[1]) + (v1[2] * v1[2] + v1[3] * v1[3]));
                }
                sq += __shfl_xor(sq, 16); sq += __shfl_xor(sq, 32);
                if (fq == 0) ssq[(size_t)row * 16 + u.pn * 4 + wc] = sq;
            }
        }
    }
};
struct EpiWin {
    static constexpr bool PERM = true, AFTER_DRAIN = false;
    bf16_t *QB, *KB, *VB, *UB; float* out; const float* ssq;
    __device__ __forceinline__ void operator()(const f32x4 (&acc)[2][2][4][2], const Unit& u, int wr, int wc, int fr, int fq) const {
        const int row0 = u.pm * 256 + wr * 64 + fr; const int pn = u.pn;
        const bool samp = u.pm >= 128;
        float rsv[8];
#pragma unroll
        for (int i = 0; i < 8; ++i) rsv[i] = rowss4<true>(ssq, row0 + (i >> 2) * 128 + (i & 3) * 16, fq);
        if (pn < 6) {
            const int sec = pn >> 1;
            bf16_t* B16 = QB + (size_t)sec * ((WS_KB - WS_QB) / 2) + (pn & 1) * 256 + wc * 32 + 8 * fq;
            const size_t fsec = sec ? (size_t)(sec - 1) : 0;
            float* fo = out + (samp ? (O_WKS - (size_t)NP * 512) + fsec * (O_WVS - O_WKS) : O_WKP + fsec * (O_WVP - O_WKP)) + (pn & 1) * 256 + wc * 32 + 8 * fq;
            const float qs = sec == 0 ? (0.125f * LOG2E) : 1.0f;
#pragma unroll
            for (int ai = 0; ai < 2; ++ai)
#pragma unroll
                for (int m = 0; m < 4; ++m) {
                    const int row = row0 + ai * 128 + m * 16; const float sc = rstd_of(rsv[ai * 4 + m]) * qs;
#pragma unroll
                    for (int bj = 0; bj < 2; ++bj) {
                        const int col = bj * 128;
                        const f32x4 v0 = acc[ai][bj][m][0] * sc, v1 = acc[ai][bj][m][1] * sc;
                        if (sec) { __builtin_nontemporal_store(v0, (f32x4*)(fo + (size_t)row * 512 + col)); __builtin_nontemporal_store(v1, (f32x4*)(fo + (size_t)row * 512 + col + 4)); }
                        u32x4 w; w.x = pk2(v0[0], v0[1]); w.y = pk2(v0[2], v0[3]); w.z = pk2(v1[0], v1[1]); w.w = pk2(v1[2], v1[3]); *(u32x4*)(B16 + (size_t)row * 512 + col) = w;
                    }
                }
        } else {
            const int c0 = (pn - 6) * 128 + wc * 32 + 8 * fq;
#pragma unroll
            for (int ai = 0; ai < 2; ++ai)
#pragma unroll
                for (int m = 0; m < 4; ++m) {
                    const int row = row0 + ai * 128 + m * 16; const float rs = rstd_of(rsv[ai * 4 + m]);
                    float* fo = nullptr;
                    if (!samp) { const int sq = row & 2047; if (sq >= 2018) fo = out + O_CP + ((size_t)(row >> 11) * 30 + (sq - 2018)) * 512 + c0; }
                    else { const int rr = row - NP; fo = out + O_CS + ((size_t)(rr >> 3) * 30 + 22 + (rr & 7)) * 512 + c0; }
                    f32x4 v[2];
#pragma unroll
                    for (int n = 0; n < 2; ++n) {
                        const f32x4 a = acc[ai][0][m][n] * rs, g = acc[ai][1][m][n] * rs;
#pragma unroll
                        for (int e = 0; e < 4; ++e) v[n][e] = a[e] * sigm_f(g[e]);
                    }
                    if (fo) { *(f32x4*)(fo) = v[0]; *(f32x4*)(fo + 4) = v[1]; }
                    u32x4 w; w.x = pk2(v[0][0], v[0][1]); w.y = pk2(v[0][2], v[0][3]); w.z = pk2(v[1][0], v[1][1]); w.w = pk2(v[1][2], v[1][3]); *(u32x4*)(UB + (size_t)row * 512 + c0) = w;
                }
        }
    }
};
struct EpiCQ {
    static constexpr bool PERM = true, AFTER_DRAIN = false;
    bf16_t* O; const float* ssq; float scale;
    __device__ __forceinline__ void operator()(const f32x4 (&acc)[2][2][4][2], const Unit& u, int wr, int wc, int fr, int fq) const {
        const int row0 = u.pm * 256 + wr * 64 + fr; const int col0 = u.pn * 256 + wc * 32 + 8 * fq;
        float rsv[8];
#pragma unroll
        for (int i = 0; i < 8; ++i) rsv[i] = rowss4<true>(ssq, row0 + (i >> 2) * 128 + (i & 3) * 16, fq);
#pragma unroll
        for (int ai = 0; ai < 2; ++ai)
#pragma unroll
            for (int m = 0; m < 4; ++m) {
                const int row = row0 + ai * 128 + m * 16; const float rs = rstd_of(rsv[ai * 4 + m]) * scale;
#pragma unroll
                for (int bj = 0; bj < 2; ++bj) {
                    const f32x4 v0 = acc[ai][bj][m][0] * rs, v1 = acc[ai][bj][m][1] * rs;
                    u32x4 w; w.x = pk2(v0[0], v0[1]); w.y = pk2(v0[2], v0[3]); w.z = pk2(v1[0], v1[1]); w.w = pk2(v1[2], v1[3]);
                    *(u32x4*)(O + (size_t)row * DM + col0 + bj * 128) = w;
                }
            }
    }
};
struct EpiMemKV {
    static constexpr bool PERM = true, AFTER_DRAIN = false;
    bf16_t *MKB, *MVB; float* out; const float* ssq;
    __device__ __forceinline__ void operator()(const f32x4 (&acc)[2][2][4][2], const Unit& u, int wr, int wc, int fr, int fq) const {
        const int row0 = u.pm * 256 + wr * 64 + fr; const bool isv = u.pn >= 4;
        bf16_t* B16 = isv ? MVB : MKB; float* fo = out + (isv ? O_MVP : O_MKP);
        float rsv[8];
#pragma unroll
        for (int i = 0; i < 8; ++i) rsv[i] = ssq[row0 + (i >> 2) * 128 + (i & 3) * 16];
#pragma unroll
        for (int ai = 0; ai < 2; ++ai)
#pragma unroll
            for (int m = 0; m < 4; ++m) {
                const int row = row0 + ai * 128 + m * 16; const float rs = rstd_of(rsv[ai * 4 + m]);
#pragma unroll
                for (int bj = 0; bj < 2; ++bj) {
                    const int col = (u.pn & 3) * 256 + bj * 128 + wc * 32 + 8 * fq;
                    const f32x4 v0 = acc[ai][bj][m][0] * rs, v1 = acc[ai][bj][m][1] * rs;
                    __builtin_nontemporal_store(v0, (f32x4*)(fo + (size_t)row * DM + col)); __builtin_nontemporal_store(v1, (f32x4*)(fo + (size_t)row * DM + col + 4));
                    u32x4 w; w.x = pk2(v0[0], v0[1]); w.y = pk2(v0[2], v0[3]); w.z = pk2(v1[0], v1[1]); w.w = pk2(v1[2], v1[3]); *(u32x4*)(B16 + (size_t)row * DM + col) = w;
                }
            }
    }
};

__device__ __forceinline__ int rowmap(int mode, int n0) {
    if (mode == 1) return (n0 >> 7) * 256 + (n0 & 127);
    if (mode == 2) return (n0 >> 7) * 256 + 128 + (n0 & 127);
    if (mode == 3) { if (n0 < 1536) return n0; if (n0 < 2048) { const int c = n0 - 1536; return 1536 + (c >> 7) * 256 + (c & 127); } const int c = n0 - 2048; return 1536 + (c >> 7) * 256 + 128 + (c & 127); }
    return n0;
}
__device__ __forceinline__ void p0_transpose_item(const float* W, int K, int N, bf16_t* WT, int mode, int row_off, const float* gain, LAS float* scr, int item, int lane) {
    const int nblk = N / 32, kb = item / nblk, nb = item % nblk, k0 = 64 * kb, n0 = 32 * nb;
#pragma unroll
    for (int i = 0; i < 32; ++i) { const int kk = 2 * i + (lane >> 5); float v = __builtin_nontemporal_load(W + (size_t)(k0 + kk) * N + n0 + (lane & 31)); if (gain) v *= gain[k0 + kk]; scr[kk * 33 + (lane & 31)] = v; }
    asm volatile("s_waitcnt lgkmcnt(0)" ::: "memory");
    const int c = lane & 7; const int drow0 = row_off + rowmap(mode, n0);
#pragma unroll
    for (int j = 0; j < 4; ++j) { const int n = (lane >> 3) + 8 * j; const LAS float* s = scr + (8 * c) * 33 + n;
        u32x4 o; o.x = pk2(s[0 * 33], s[1 * 33]); o.y = pk2(s[2 * 33], s[3 * 33]); o.z = pk2(s[4 * 33], s[5 * 33]); o.w = pk2(s[6 * 33], s[7 * 33]);
        *(u32x4*)(WT + (size_t)(drow0 + n) * K + k0 + 8 * c) = o; }
    asm volatile("s_waitcnt lgkmcnt(0)" ::: "memory");
}
__device__ __forceinline__ void row_to_bf16(const float* xrow, bf16_t* orow, float* ssq_out, int lane) {
    const f32x4* xr = (const f32x4*)xrow + lane; f32x4 v[4]; float s = 0.f;
#pragma unroll
    for (int j = 0; j < 4; ++j) { v[j] = xr[64 * j]; s += (v[j][0] * v[j][0] + v[j][1] * v[j][1]) + (v[j][2] * v[j][2] + v[j][3] * v[j][3]); }
    s = wave_sum(s);
    u32x2* o8 = (u32x2*)orow + lane;
#pragma unroll
    for (int j = 0; j < 4; ++j) { u32x2 w; w.x = pk2(v[j][0], v[j][1]); w.y = pk2(v[j][2], v[j][3]); o8[64 * j] = w; }
    if (lane == 0) *ssq_out = s;
}

__device__ __forceinline__ void row2_to_bf16(const float* xa, const float* xb, bf16_t* oa, bf16_t* ob, float* sa, float* sb, int lane) {
    const f32x4* pa = (const f32x4*)xa + lane; const f32x4* pb = (const f32x4*)xb + lane; f32x4 va[4], vb[4]; float s0 = 0.f, s1 = 0.f;
#pragma unroll
    for (int j = 0; j < 4; ++j) { va[j] = __builtin_nontemporal_load(pa + 64 * j); vb[j] = __builtin_nontemporal_load(pb + 64 * j); }
#pragma unroll
    for (int j = 0; j < 4; ++j) { s0 += (va[j][0] * va[j][0] + va[j][1] * va[j][1]) + (va[j][2] * va[j][2] + va[j][3] * va[j][3]); s1 += (vb[j][0] * vb[j][0] + vb[j][1] * vb[j][1]) + (vb[j][2] * vb[j][2] + vb[j][3] * vb[j][3]); }
    s0 = wave_sum(s0); s1 = wave_sum(s1);
    u32x2* qa = (u32x2*)oa + lane; u32x2* qb = (u32x2*)ob + lane;
#pragma unroll
    for (int j = 0; j < 4; ++j) { u32x2 w; w.x = pk2(va[j][0], va[j][1]); w.y = pk2(va[j][2], va[j][3]); qa[64 * j] = w; u32x2 z; z.x = pk2(vb[j][0], vb[j][1]); z.y = pk2(vb[j][2], vb[j][3]); qb[64 * j] = z; }
    if (lane == 0) { *sa = s0; *sb = s1; }
}

constexpr int AT_MB_PITCH = 68;
constexpr int AT_MB_BYTES = 256 * AT_MB_PITCH * 4;
constexpr int AT_VP = 144;
constexpr int AT_VS_BYTES = 2 * 32 * AT_VP;
__device__ __forceinline__ s16x4 lds_tr(const LAS unsigned char* p) {
    typedef short v4i16_t __attribute__((ext_vector_type(4)));
    return __builtin_bit_cast(s16x4, __builtin_amdgcn_ds_read_tr16_b64_v4i16((LAS v4i16_t*)p));
}
template <int NQ> __device__ __forceinline__ void attn_tile(LAS float* MBuf, LAS unsigned char* vs, const bf16_t* QB, const bf16_t* KB, const bf16_t* VB, bf16_t* MIX,
                                                            size_t rowb, int h, int p0, int br, int r, int i0, float slope2, int lane) {
    const int fr = lane & 15, fq = lane >> 4, tq = fr >> 2, tp = fr & 3;
    const int sh = 2 * br, L = SEQ >> sh;
    int qi[NQ], qpos[NQ]; bf16x8 q0[NQ], q1[NQ]; float m_run[NQ], l_run[NQ]; f32x4 o[NQ][4];
#pragma unroll
    for (int t = 0; t < NQ; ++t) {
        qi[t] = i0 + 16 * t + fr; qpos[t] = (qi[t] << sh) + r;
        const bf16_t* qp = QB + (rowb + qpos[t]) * 512 + h * 64 + fq * 8;
        q0[t] = *(const bf16x8*)qp; q1[t] = *(const bf16x8*)(qp + 32);
        m_run[t] = -INFINITY; l_run[t] = 0.f;
#pragma unroll
        for (int dt = 0; dt < 4; ++dt) o[t][dt] = (f32x4){0.f, 0.f, 0.f, 0.f};
    }
    const bf16_t* kbase = KB + (rowb + r) * 512 + h * 64 + (lane & 7) * 8;
    const bf16_t* vbase = VB + (rowb + r) * 512 + h * 64 + (lane & 7) * 8;
    int pi_lo = (128 - i0) >> 5; pi_lo = pi_lo < 0 ? 0 : pi_lo;
    bf16x8 kf[4]; u32x4 vv[4];
#define AT_LOAD_PAIR(KF, VV, PI) do { const int kb0_ = i0 - 128 + 32 * (PI); \
        _Pragma("unroll") for (int vi_ = 0; vi_ < 4; ++vi_) { int kj_ = kb0_ + 8 * vi_ + (lane >> 3); kj_ = kj_ < 0 ? 0 : (kj_ > L - 1 ? L - 1 : kj_); \
            KF[vi_] = *(const bf16x8*)(kbase + (size_t)(kj_ << sh) * 512); VV[vi_] = *(const u32x4*)(vbase + (size_t)(kj_ << sh) * 512); } } while (0)
    AT_LOAD_PAIR(kf, vv, pi_lo);
#pragma unroll 1
    for (int pi = pi_lo; pi < 5; ++pi) {
        bf16x8 nkf[4]; u32x4 nvv[4];
        { const int pn = pi + 1 < 5 ? pi + 1 : 4; AT_LOAD_PAIR(nkf, nvv, pn); }
        const int kb0 = i0 - 128 + 32 * pi;
        { LAS unsigned char* vd = vs + (lane >> 3) * AT_VP + (lane & 7) * 16;
#pragma unroll
          for (int vi = 0; vi < 4; ++vi) { *(LAS u32x4*)(vd + 8 * vi * AT_VP) = vv[vi]; *(LAS bf16x8*)(vd + 32 * AT_VP + 8 * vi * AT_VP) = kf[vi]; } }
        bf16x8 kfr[4];
        { const LAS unsigned char* kr = vs + 32 * AT_VP + fr * AT_VP + fq * 16;
          kfr[0] = *(const LAS bf16x8*)kr; kfr[1] = *(const LAS bf16x8*)(kr + 64); kfr[2] = *(const LAS bf16x8*)(kr + 16 * AT_VP); kfr[3] = *(const LAS bf16x8*)(kr + 16 * AT_VP + 64); }
        bf16x8 pf[NQ];
#pragma unroll
        for (int t = 0; t < NQ; ++t) {
            f32x4 sa = (f32x4){0.f, 0.f, 0.f, 0.f}, sb = (f32x4){0.f, 0.f, 0.f, 0.f};
            sa = __builtin_amdgcn_mfma_f32_16x16x32_bf16(kfr[0], q0[t], sa, 0, 0, 0); sa = __builtin_amdgcn_mfma_f32_16x16x32_bf16(kfr[1], q1[t], sa, 0, 0, 0);
            sb = __builtin_amdgcn_mfma_f32_16x16x32_bf16(kfr[2], q0[t], sb, 0, 0, 0); sb = __builtin_amdgcn_mfma_f32_16x16x32_bf16(kfr[3], q1[t], sb, 0, 0, 0);
            float sc[8]; float mx = -INFINITY;
            if (pi >= 1 && pi <= 3 && kb0 >= 0) {
                const float bstep = slope2 * (float)(1 << sh);
                const float b0 = -bstep * (float)(qi[t] - kb0 - 4 * fq), b1 = b0 + 16.0f * bstep;
#pragma unroll
                for (int e = 0; e < 4; ++e) { sc[e] = sa[e] + (b0 + bstep * (float)e); sc[4 + e] = sb[e] + (b1 + bstep * (float)e); mx = fmaxf(mx, fmaxf(sc[e], sc[4 + e])); }
            } else {
#pragma unroll
            for (int e = 0; e < 4; ++e) {
                const int keya = kb0 + 4 * fq + e, da = qi[t] - keya;
                const bool va = (keya >= 0) && (da >= 0) && (da <= 128);
                sc[e] = va ? sa[e] - slope2 * (float)(da << sh) : -INFINITY;
                const int keyb = keya + 16, db = qi[t] - keyb;
                const bool vb = (keyb >= 0) && (db >= 0) && (db <= 128);
                sc[4 + e] = vb ? sb[e] - slope2 * (float)(db << sh) : -INFINITY;
                mx = fmaxf(mx, fmaxf(sc[e], sc[4 + e]));
            }
            }
            mx = fmaxf(mx, __shfl_xor(mx, 16)); mx = fmaxf(mx, __shfl_xor(mx, 32));
            const float m_new = fmaxf(m_run[t], mx);
            const float mref = (m_new == -INFINITY) ? 0.f : m_new;
            const float alpha = fexp2(m_run[t] - mref);
            float p[8]; float ps = 0.f;
#pragma unroll
            for (int e = 0; e < 8; ++e) { p[e] = fexp2(sc[e] - mref); ps += p[e]; }
            l_run[t] = l_run[t] * alpha + ps; m_run[t] = m_new;
#pragma unroll
            for (int dt = 0; dt < 4; ++dt) o[t][dt] = o[t][dt] * alpha;
            u32x4 pw; pw.x = pk2(p[0], p[1]); pw.y = pk2(p[2], p[3]); pw.z = pk2(p[4], p[5]); pw.w = pk2(p[6], p[7]);
            pf[t] = __builtin_bit_cast(bf16x8, pw);
        }
        const LAS unsigned char* tb = vs + (4 * fq + tq) * AT_VP + tp * 8;
#pragma unroll
        for (int dt = 0; dt < 4; ++dt) {
            const s16x4 a = lds_tr(tb + dt * 32), bb = lds_tr(tb + 16 * AT_VP + dt * 32);
            const bf16x8 vf = (bf16x8){a[0], a[1], a[2], a[3], bb[0], bb[1], bb[2], bb[3]};
#pragma unroll
            for (int t = 0; t < NQ; ++t) o[t][dt] = __builtin_amdgcn_mfma_f32_16x16x32_bf16(vf, pf[t], o[t][dt], 0, 0, 0);
        }
#pragma unroll
        for (int i = 0; i < 4; ++i) { kf[i] = nkf[i]; vv[i] = nvv[i]; }
    }
#undef AT_LOAD_PAIR
#pragma unroll
    for (int t = 0; t < NQ; ++t) {
        float lr = l_run[t]; lr += __shfl_xor(lr, 16); lr += __shfl_xor(lr, 32);
        const float mr = m_run[t];
        LAS float* mrow = MBuf + (qpos[t] - p0) * AT_MB_PITCH;
        if (br == 0) {
#pragma unroll
            for (int dt = 0; dt < 4; ++dt) *(LAS f32x4*)(mrow + dt * 16 + 4 * fq) = o[t][dt];
            if (fq == 0) { mrow[64] = mr; mrow[65] = lr; }
        } else {
            const float m0 = mrow[64], l0 = mrow[65];
            const float mm = fmaxf(m0, mr); const float a0 = fexp2(m0 - mm), a1 = fexp2(mr - mm);
            const float ll = a0 * l0 + a1 * lr;
            f32x4 om[4];
#pragma unroll
            for (int dt = 0; dt < 4; ++dt) om[dt] = *(LAS f32x4*)(mrow + dt * 16 + 4 * fq) * a0 + o[t][dt] * a1;
            if (br == 1) {
#pragma unroll
                for (int dt = 0; dt < 4; ++dt) *(LAS f32x4*)(mrow + dt * 16 + 4 * fq) = om[dt];
                if (fq == 0) { mrow[64] = mm; mrow[65] = ll; }
            } else {
                const float inv = 1.0f / ll;
                bf16_t* op = MIX + (rowb + qpos[t]) * DM + h * 64 + 4 * fq;
#pragma unroll
                for (int dt = 0; dt < 4; ++dt) { u32x2 w; w.x = pk2(om[dt][0] * inv, om[dt][1] * inv); w.y = pk2(om[dt][2] * inv, om[dt][3] * inv); *(u32x2*)(op + dt * 16) = w; }
            }
        }
    }
}
__device__ __forceinline__ void attn_prompt_unit(LAS unsigned char* lds, const bf16_t* QB, const bf16_t* KB, const bf16_t* VB, bf16_t* MIX, int b, int h, int blk, int wave, int lane) {
    LAS float* MBuf = (LAS float*)lds;
    LAS unsigned char* vs = lds + AT_MB_BYTES + wave * AT_VS_BYTES;
    const int p0 = blk * 256;
    const float slope2 = fexp2(-(float)(h + 1)) * LOG2E;
    const size_t rowb = (size_t)b * SEQ;
    attn_tile<2>(MBuf, vs, QB, KB, VB, MIX, rowb, h, p0, 0, 0, p0 + 32 * wave, slope2, lane);
    __syncthreads();
    attn_tile<2>(MBuf, vs, QB, KB, VB, MIX, rowb, h, p0, 1, wave & 3, (p0 >> 2) + 32 * (wave >> 2), slope2, lane);
    __syncthreads();
#pragma unroll 1
    for (int tt2 = 0; tt2 < 2; ++tt2) attn_tile<1>(MBuf, vs, QB, KB, VB, MIX, rowb, h, p0, 2, 2 * wave + tt2, p0 >> 4, slope2, lane);
    __syncthreads();
}

__device__ __forceinline__ void attn_sample_unit(LAS unsigned char* lds, const bf16_t* QB, const float* cwk, const float* cwv, const float* out, bf16_t* MIX, int b, int h, int wave, int lane) {
    const int t = wave, sub = lane & 15, g = lane >> 4;
    const int row = NP + b * 8 + t;
    const float slope2 = fexp2(-(float)(h + 1)) * LOG2E;
    float q[4];
    { const u32x2 qw = *(const u32x2*)(QB + (size_t)row * 512 + h * 64 + 4 * sub); q[0] = bflo(qw.x); q[1] = bfhi(qw.x); q[2] = bflo(qw.y); q[3] = bfhi(qw.y); }
    float m = -INFINITY, l = 0.f; f32x4 acc = (f32x4){0.f, 0.f, 0.f, 0.f};
#pragma unroll 1
    for (int it0 = 0; it0 < 112; it0 += 16) {
        f32x4 k4[16], v4[16]; float s[16];
#pragma unroll
        for (int i = 0; i < 16; ++i) {
            const int idx = (it0 + i) * 4 + g; const int idc = idx > 386 ? 386 : idx;
            const int br = idc / 129, j = idc - br * 129; const int dist = j << (2 * br);
            const int uu = 2048 + t - dist;
            const size_t offn = (size_t)(b * 8 + (uu - 2048)) * 512 + h * 64 + 4 * sub, offc = ((size_t)(b * 2048 + uu) * 8 + h) * 64 + 4 * sub;
            k4[i] = *(const f32x4*)((uu >= 2048) ? out + O_WKS + offn : cwk + offc);
            v4[i] = *(const f32x4*)((uu >= 2048) ? out + O_WVS + offn : cwv + offc);
        }
        float bm = -INFINITY;
#pragma unroll
        for (int i = 0; i < 16; ++i) {
            const int idx = (it0 + i) * 4 + g; const int idc = idx > 386 ? 386 : idx;
            const int br = idc / 129, j = idc - br * 129; const int dist = j << (2 * br);
            float d = (q[0] * k4[i][0] + q[1] * k4[i][1]) + (q[2] * k4[i][2] + q[3] * k4[i][3]);
            d += __shfl_xor(d, 1); d += __shfl_xor(d, 2); d += __shfl_xor(d, 4); d += __shfl_xor(d, 8);
            d -= slope2 * (float)dist;
            s[i] = idx <= 386 ? d : -INFINITY; bm = fmaxf(bm, s[i]);
        }
        const float m_new = fmaxf(m, bm); const float mref = (m_new == -INFINITY) ? 0.f : m_new;
        const float alpha = fexp2(m - mref);
        l *= alpha; acc = acc * alpha; m = m_new;
#pragma unroll
        for (int i = 0; i < 16; ++i) { const float p = fexp2(s[i] - mref); l += p; acc = acc + v4[i] * p; }
    }
    float mall = fmaxf(m, __shfl_xor(m, 16)); mall = fmaxf(mall, __shfl_xor(mall, 32));
    const float sc = fexp2(m - mall);
    l *= sc; acc = acc * sc;
#pragma unroll
    for (int e = 0; e < 4; ++e) { acc[e] += __shfl_xor(acc[e], 16); acc[e] += __shfl_xor(acc[e], 32); }
    l += __shfl_xor(l, 16); l += __shfl_xor(l, 32);
    if (g == 0) { const float inv = 1.0f / l; u32x2 w; w.x = pk2(acc[0] * inv, acc[1] * inv); w.y = pk2(acc[2] * inv, acc[3] * inv);
        *(u32x2*)(MIX + (size_t)row * DM + h * 64 + 4 * sub) = w; }
}

constexpr int CV_TILE_BYTES = 94 * 1024;
__device__ __forceinline__ void conv_unit(LAS unsigned char* lds, int kind, int b, int p0, const bf16_t* UB, const float* cconv, const float* cw, const float* cb, const float* lng, const float* lnb,
                                          bf16_t* MIX, int tid, int wave, int lane) {
    LAS unsigned* T = (LAS unsigned*)lds;
    LAS float* ST = (LAS float*)(lds + CV_TILE_BYTES);
    if (kind == 0) {
        u32x4 w[12];
#pragma unroll
        for (int i = 0; i < 12; ++i) { const int id = tid + NTHREADS * i, rr = id >> 6, c8 = id & 63; const int pos = p0 - 30 + rr;
            w[i] = (u32x4){0u, 0u, 0u, 0u}; if (id < 94 * 64 && pos >= 0) w[i] = *(const u32x4*)(UB + ((size_t)b * SEQ + pos) * 512 + c8 * 8); }
#pragma unroll
        for (int i = 0; i < 12; ++i) { const int id = tid + NTHREADS * i, rr = id >> 6, c8 = id & 63; if (id < 94 * 64) *(LAS u32x4*)(lds + rr * 1024 + c8 * 16) = w[i]; }
    } else
    for (int id = tid; id < 94 * 64; id += NTHREADS) {
        const int rr = id >> 6, c8 = id & 63; u32x4 w = (u32x4){0u, 0u, 0u, 0u};
        if (rr < 30) { const f32x4* s = (const f32x4*)(cconv + ((size_t)b * 30 + rr) * 512 + c8 * 8); const f32x4 a = s[0], c = s[1];
            w.x = pk2(a[0], a[1]); w.y = pk2(a[2], a[3]); w.z = pk2(c[0], c[1]); w.w = pk2(c[2], c[3]); }
        else if (rr < 38) w = *(const u32x4*)(UB + ((size_t)NP + b * 8 + (rr - 30)) * 512 + c8 * 8);
        *(LAS u32x4*)(lds + rr * 1024 + c8 * 16) = w;
    }
    const int cp = tid & 255, half = tid >> 8, w4 = wave & 3;
    typedef __bf16 bf2_t __attribute__((ext_vector_type(2)));
    unsigned w0[31], w1[31];
#pragma unroll
    for (int j = 0; j < 31; ++j) { const f32x2 ww = *(const f32x2*)(cw + j * 512 + 2 * cp); w0[j] = pk2(ww[0], 0.f); w1[j] = pk2(0.f, ww[1]); }
    const f32x2 cbv = *(const f32x2*)(cb + 2 * cp), gv = *(const f32x2*)(lng + 2 * cp), bv = *(const f32x2*)(lnb + 2 * cp);
    __syncthreads();
    const int nchunks = kind == 0 ? 4 : 1;
    const size_t orow0 = kind == 0 ? (size_t)b * SEQ + p0 : (size_t)NP + b * 8;
#pragma unroll 1
    for (int ch = 0; ch < nchunks; ++ch) {
        float a0[8], a1[8];
#pragma unroll
        for (int pp = 0; pp < 8; ++pp) {
            const int pl = half * 32 + ch * 8 + pp;
            float c0 = cbv[0], c1 = cbv[1];
#pragma unroll
            for (int j = 0; j < 31; ++j) { const unsigned uu = T[(pl + j) * 256 + cp];
                c0 = __builtin_amdgcn_fdot2_f32_bf16(__builtin_bit_cast(bf2_t, uu), __builtin_bit_cast(bf2_t, w0[j]), c0, false);
                c1 = __builtin_amdgcn_fdot2_f32_bf16(__builtin_bit_cast(bf2_t, uu), __builtin_bit_cast(bf2_t, w1[j]), c1, false); }
            a0[pp] = c0; a1[pp] = c1;
            asm volatile("" ::: "memory");
        }
        {
            float r[16];
#pragma unroll
            for (int pp = 0; pp < 8; ++pp) { r[2 * pp] = a0[pp] + a1[pp]; r[2 * pp + 1] = a0[pp] * a0[pp] + a1[pp] * a1[pp]; }
            { const bool bt = (lane & 32) != 0;
#pragma unroll
              for (int i = 0; i < 8; ++i) { const float snd = bt ? r[i] : r[i + 8], kp = bt ? r[i + 8] : r[i]; r[i] = kp + __shfl_xor(snd, 32); } }
            { const bool bt = (lane & 16) != 0;
#pragma unroll
              for (int i = 0; i < 4; ++i) { const float snd = bt ? r[i] : r[i + 4], kp = bt ? r[i + 4] : r[i]; r[i] = kp + __shfl_xor(snd, 16); } }
            { const bool bt = (lane & 8) != 0;
#pragma unroll
              for (int i = 0; i < 2; ++i) { const float snd = bt ? r[i] : r[i + 2], kp = bt ? r[i + 2] : r[i]; r[i] = kp + __shfl_xor(snd, 8); } }
            { const bool bt = (lane & 4) != 0; const float snd = bt ? r[0] : r[1], kp = bt ? r[1] : r[0]; r[0] = kp + __shfl_xor(snd, 4); }
            r[0] += __shfl_xor(r[0], 2); r[0] += __shfl_xor(r[0], 1);
            if ((lane & 3) == 0) { const int v = ((lane >> 5) & 1) * 8 + ((lane >> 4) & 1) * 4 + ((lane >> 3) & 1) * 2 + ((lane >> 2) & 1);
                ST[((half * 8 + (v >> 1)) * 4 + w4) * 2 + (v & 1)] = r[0]; }
        }
        __syncthreads();
        const bool valid = kind == 0 || half == 0;
#pragma unroll
        for (int pp = 0; pp < 8; ++pp) {
            const LAS float* sp = ST + (half * 8 + pp) * 8;
            const float S1 = (sp[0] + sp[2]) + (sp[4] + sp[6]), S2 = (sp[1] + sp[3]) + (sp[5] + sp[7]);
            const float mean = S1 * (1.0f / 512.0f); const float var = S2 * (1.0f / 512.0f) - mean * mean;
            const float rstd = __builtin_amdgcn_rsqf(fmaxf(var, 0.f) + EPS);
            const float y0 = (a0[pp] - mean) * rstd * gv[0] + bv[0], y1 = (a1[pp] - mean) * rstd * gv[1] + bv[1];
            if (valid) *(unsigned*)(MIX + (orow0 + half * 32 + ch * 8 + pp) * DM + 512 + 2 * cp) = pk2(silu_f(y0), silu_f(y1));
        }
        __syncthreads();
    }
}

constexpr int XA_KP = 528, XA_VP = 544;
__device__ __forceinline__ void xattn_unit(LAS unsigned char* lds, const void* Kp, const void* Vp, bool kvf32, int pitch, const bf16_t* QX, bf16_t* OX, int qrow0, int nq, int h, int tid, int wave, int lane) {
    const int fr = lane & 15, fq = lane >> 4;
    if (!kvf32) {
        u32x4 w[16];
#pragma unroll
        for (int i = 0; i < 16; ++i) { const int id = tid + NTHREADS * i, rr = id >> 5, c = id & 31; w[i] = *(const u32x4*)((const bf16_t*)Kp + (size_t)rr * pitch + c * 8); }
#pragma unroll
        for (int i = 0; i < 16; ++i) { const int id = tid + NTHREADS * i, rr = id >> 5, c = id & 31; *(LAS u32x4*)(lds + rr * XA_KP + c * 16) = w[i]; }
    } else {
#pragma unroll 1
        for (int i0 = 0; i0 < 16; i0 += 8) {
            f32x4 fa[8], fd[8];
#pragma unroll
            for (int i = 0; i < 8; ++i) { const int id = tid + NTHREADS * (i0 + i), rr = id >> 5, c = id & 31; const f32x4* sp = (const f32x4*)((const float*)Kp + (size_t)rr * pitch + c * 8); fa[i] = __builtin_nontemporal_load(sp); fd[i] = __builtin_nontemporal_load(sp + 1); }
#pragma unroll
            for (int i = 0; i < 8; ++i) { const int id = tid + NTHREADS * (i0 + i), rr = id >> 5, c = id & 31; u32x4 w; w.x = pk2(fa[i][0], fa[i][1]); w.y = pk2(fa[i][2], fa[i][3]); w.z = pk2(fd[i][0], fd[i][1]); w.w = pk2(fd[i][2], fd[i][3]);
                *(LAS u32x4*)(lds + rr * XA_KP + c * 16) = w; }
        }
    }
    __syncthreads();
    const bool active = 16 * wave < nq;
    int qr = qrow0 + 16 * wave + fr; if (qr > qrow0 + nq - 1) qr = qrow0 + nq - 1;
    bf16x8 pf[8]; float linv = 0.f;
    if (active) {
        bf16x8 qf[8];
        const bf16_t* qp = QX + (size_t)qr * DM + h * 256 + fq * 8;
#pragma unroll
        for (int ks = 0; ks < 8; ++ks) qf[ks] = *(const bf16x8*)(qp + ks * 32);
        f32x4 s[16]; float mx = -INFINITY;
#pragma unroll
        for (int c = 0; c < 16; ++c) {
            f32x4 a = (f32x4){0.f, 0.f, 0.f, 0.f};
            const LAS unsigned char* kr = lds + (16 * c + fr) * XA_KP + fq * 16;
#pragma unroll
            for (int ks = 0; ks < 8; ++ks) a = __builtin_amdgcn_mfma_f32_16x16x32_bf16(*(const LAS bf16x8*)(kr + ks * 64), qf[ks], a, 0, 0, 0);
            s[c] = a; mx = fmaxf(fmaxf(mx, fmaxf(a[0], a[1])), fmaxf(a[2], a[3]));
        }
        mx = fmaxf(mx, __shfl_xor(mx, 16)); mx = fmaxf(mx, __shfl_xor(mx, 32));
        float l = 0.f;
#pragma unroll
        for (int c = 0; c < 16; ++c) {
#pragma unroll
            for (int e = 0; e < 4; ++e) { s[c][e] = fexp2(s[c][e] - mx); l += s[c][e]; }
        }
        l += __shfl_xor(l, 16); l += __shfl_xor(l, 32); linv = 1.0f / l;
#pragma unroll
        for (int k2 = 0; k2 < 8; ++k2) { u32x4 pw; pw.x = pk2(s[2 * k2][0], s[2 * k2][1]); pw.y = pk2(s[2 * k2][2], s[2 * k2][3]); pw.z = pk2(s[2 * k2 + 1][0], s[2 * k2 + 1][1]); pw.w = pk2(s[2 * k2 + 1][2], s[2 * k2 + 1][3]);
            pf[k2] = __builtin_bit_cast(bf16x8, pw); }
    }
    __syncthreads();
    if (!kvf32) {
        u32x4 w[16];
#pragma unroll
        for (int i = 0; i < 16; ++i) { const int id = tid + NTHREADS * i, rr = id >> 5, c = id & 31; w[i] = *(const u32x4*)((const bf16_t*)Vp + (size_t)rr * pitch + c * 8); }
#pragma unroll
        for (int i = 0; i < 16; ++i) { const int id = tid + NTHREADS * i, rr = id >> 5, c = id & 31; *(LAS u32x4*)(lds + rr * XA_VP + c * 16) = w[i]; }
    } else {
#pragma unroll 1
        for (int i0 = 0; i0 < 16; i0 += 8) {
            f32x4 fa[8], fd[8];
#pragma unroll
            for (int i = 0; i < 8; ++i) { const int id = tid + NTHREADS * (i0 + i), rr = id >> 5, c = id & 31; const f32x4* sp = (const f32x4*)((const float*)Vp + (size_t)rr * pitch + c * 8); fa[i] = __builtin_nontemporal_load(sp); fd[i] = __builtin_nontemporal_load(sp + 1); }
#pragma unroll
            for (int i = 0; i < 8; ++i) { const int id = tid + NTHREADS * (i0 + i), rr = id >> 5, c = id & 31; u32x4 w; w.x = pk2(fa[i][0], fa[i][1]); w.y = pk2(fa[i][2], fa[i][3]); w.z = pk2(fd[i][0], fd[i][1]); w.w = pk2(fd[i][2], fd[i][3]);
                *(LAS u32x4*)(lds + rr * XA_VP + c * 16) = w; }
        }
    }
    __syncthreads();
    if (active) {
        const int tq = fr >> 2, tp = fr & 3;
        const LAS unsigned char* tb = lds + (4 * fq + tq) * XA_VP + tp * 8;
        const bool wr_ok = 16 * wave + fr < nq;
        bf16_t* op = OX + (size_t)qr * DM + h * 256 + 4 * fq;
#pragma unroll 4
        for (int dt = 0; dt < 16; ++dt) {
            f32x4 o = (f32x4){0.f, 0.f, 0.f, 0.f};
#pragma unroll
            for (int k2 = 0; k2 < 8; ++k2) {
                const s16x4 a = lds_tr(tb + (32 * k2) * XA_VP + dt * 32), bb = lds_tr(tb + (32 * k2 + 16) * XA_VP + dt * 32);
                const bf16x8 vf = (bf16x8){a[0], a[1], a[2], a[3], bb[0], bb[1], bb[2], bb[3]};
                o = __builtin_amdgcn_mfma_f32_16x16x32_bf16(vf, pf[k2], o, 0, 0, 0);
            }
            if (wr_ok) { u32x2 w; w.x = pk2(o[0] * linv, o[1] * linv); w.y = pk2(o[2] * linv, o[3] * linv); *(u32x2*)(op + dt * 16) = w; }
        }
    }
    __syncthreads();
}


constexpr int SG_PITCH = 528;
constexpr int SG_WAVE_BYTES = 32 * SG_PITCH;
template <int NT, int UNR> __device__ __forceinline__ void sgemm(LAS unsigned char* lds, const bf16_t* A, const bf16_t* Bt, int K, const int (&brow)[NT], int wave, int lane, f32x4 (&acc)[2][NT]) {
    static_assert(UNR == 8, "one staged block = 8 k-steps");
    const int fr = lane & 15, fq = lane >> 4;
    LAS unsigned char* st = lds + wave * SG_WAVE_BYTES;
    const bf16_t* ar = A + (size_t)(32 * wave + (lane >> 3)) * K + (lane & 7) * 8;
    LAS unsigned char* wr = st + (lane >> 3) * SG_PITCH + (lane & 7) * 16;
    const LAS unsigned char* rd = st + fr * SG_PITCH + fq * 16;
    const bf16_t* bp[NT];
#pragma unroll
    for (int nt = 0; nt < NT; ++nt) { bp[nt] = Bt + (size_t)brow[nt] * K + fq * 8; acc[0][nt] = (f32x4){0.f, 0.f, 0.f, 0.f}; acc[1][nt] = (f32x4){0.f, 0.f, 0.f, 0.f}; }
    const int nks = K / 32;
#pragma unroll 1
    for (int k0 = 0; k0 < nks; k0 += 8) {
        bf16x8 al[4][4], bf[8][NT];
#pragma unroll
        for (int rg = 0; rg < 4; ++rg)
#pragma unroll
            for (int ln = 0; ln < 4; ++ln) al[rg][ln] = *(const bf16x8*)(ar + (size_t)(8 * rg) * K + k0 * 32 + ln * 64);
#pragma unroll
        for (int u = 0; u < 8; ++u)
#pragma unroll
            for (int nt = 0; nt < NT; ++nt) bf[u][nt] = *(const bf16x8*)(bp[nt] + (k0 + u) * 32);
#pragma unroll
        for (int rg = 0; rg < 4; ++rg)
#pragma unroll
            for (int ln = 0; ln < 4; ++ln) *(LAS bf16x8*)(wr + (8 * rg) * SG_PITCH + ln * 128) = al[rg][ln];
#pragma unroll
        for (int u = 0; u < 8; ++u) {
            const bf16x8 af0 = *(const LAS bf16x8*)(rd + u * 64), af1 = *(const LAS bf16x8*)(rd + 16 * SG_PITCH + u * 64);
#pragma unroll
            for (int nt = 0; nt < NT; ++nt) {
                acc[0][nt] = __builtin_amdgcn_mfma_f32_16x16x32_bf16(bf[u][nt], af0, acc[0][nt], 0, 0, 0); acc[1][nt] = __builtin_amdgcn_mfma_f32_16x16x32_bf16(bf[u][nt], af1, acc[1][nt], 0, 0, 0); }
        }
    }
}
template <int NT> __device__ __forceinline__ void sgemm1(LAS unsigned char* lds, const bf16_t* A, const bf16_t* Bt, int K, const int (&brow)[NT], int row0, int wave, int lane, f32x4 (&acc)[NT]) {
    const int fr = lane & 15, fq = lane >> 4;
    LAS unsigned char* st = lds + wave * SG_WAVE_BYTES;
    const bf16_t* ar = A + (size_t)(row0 + 16 * wave + (lane >> 3)) * K + (lane & 7) * 8;
    LAS unsigned char* wr = st + (lane >> 3) * SG_PITCH + (lane & 7) * 16;
    const LAS unsigned char* rd = st + fr * SG_PITCH + fq * 16;
    const bf16_t* bp[NT];
#pragma unroll
    for (int nt = 0; nt < NT; ++nt) { bp[nt] = Bt + (size_t)brow[nt] * K + fq * 8; acc[nt] = (f32x4){0.f, 0.f, 0.f, 0.f}; }
    const int nks = K / 32;
    bf16x8 al[2][4], bf[8][NT];
#define SG1_LOAD(AL, BF, K0) do { _Pragma("unroll") for (int rg_ = 0; rg_ < 2; ++rg_) _Pragma("unroll") for (int ln_ = 0; ln_ < 4; ++ln_) AL[rg_][ln_] = *(const bf16x8*)(ar + (size_t)(8 * rg_) * K + (K0) * 32 + ln_ * 64); \
        _Pragma("unroll") for (int u_ = 0; u_ < 8; ++u_) _Pragma("unroll") for (int nt_ = 0; nt_ < NT; ++nt_) BF[u_][nt_] = *(const bf16x8*)(bp[nt_] + ((K0) + u_) * 32); } while (0)
    SG1_LOAD(al, bf, 0);
#pragma unroll 1
    for (int k0 = 0; k0 < nks; k0 += 8) {
        bf16x8 nal[2][4], nbf[8][NT];
        { const int kn = k0 + 8 < nks ? k0 + 8 : k0; SG1_LOAD(nal, nbf, kn); }
#pragma unroll
        for (int rg = 0; rg < 2; ++rg)
#pragma unroll
            for (int ln = 0; ln < 4; ++ln) *(LAS bf16x8*)(wr + (8 * rg) * SG_PITCH + ln * 128) = al[rg][ln];
#pragma unroll
        for (int u = 0; u < 8; ++u) {
            const bf16x8 af0 = *(const LAS bf16x8*)(rd + u * 64);
#pragma unroll
            for (int nt = 0; nt < NT; ++nt) acc[nt] = __builtin_amdgcn_mfma_f32_16x16x32_bf16(bf[u][nt], af0, acc[nt], 0, 0, 0);
        }
#pragma unroll
        for (int rg = 0; rg < 2; ++rg)
#pragma unroll
            for (int ln = 0; ln < 4; ++ln) al[rg][ln] = nal[rg][ln];
#pragma unroll
        for (int u = 0; u < 8; ++u)
#pragma unroll
            for (int nt = 0; nt < NT; ++nt) bf[u][nt] = nbf[u][nt];
    }
#undef SG1_LOAD
}
template <bool PART> __device__ __forceinline__ void s_gu(LAS unsigned char* lds, const bf16_t* XBs, const bf16_t* Wgu, bf16_t* ACT, const float* ssq, int s, int wave, int lane) {
    const int fr = lane & 15, fq = lane >> 4;
    int j = 11 * s + fr; j = j > FF - 1 ? FF - 1 : j;
    int brow[2]; brow[0] = (j >> 7) * 256 + (j & 127); brow[1] = brow[0] + 128;
    f32x4 acc[2][2]; sgemm<2, 8>(lds, XBs, Wgu, DM, brow, wave, lane, acc);
#pragma unroll
    for (int mt = 0; mt < 2; ++mt) { const int r = NP + 32 * wave + 16 * mt + fr; const float rs = rstd_of(PART ? samp_ss(ssq, r - NP, fq) : ssq[r]);
#pragma unroll
        for (int e = 0; e < 4; ++e) if (4 * fq + e < 11) { const float g = acc[mt][0][e] * rs, up = acc[mt][1][e] * rs;
            ACT[(size_t)r * FF + 11 * s + 4 * fq + e] = (bf16_t)(pk2(silu_f(g) * up, 0.f) & 0xffffu); } }
}
template <bool BASE_F32, bool OUT_F32> __device__ __forceinline__ void s_res(LAS unsigned char* lds, const bf16_t* As, int K, const bf16_t* Wt, const float* base_s, float* X, bf16_t* XB, float* ssq, float scale, int s, int wave, int lane) {
    const int fr = lane & 15, fq = lane >> 4;
    const int rg = s & 1, cg = s >> 1;
    int brow[1]; brow[0] = 8 * cg + (fr < 7 ? fr : 7);
    f32x4 acc[1]; sgemm1<1>(lds, As, Wt, K, brow, 128 * rg, wave, lane, acc);
    const int rr = 128 * rg + 16 * wave + fr, r = NP + rr; const int col = 8 * cg + 4 * (fq & 1);
    float sq = 0.f;
    if (fq < 2) {
        f32x4 b;
        if (BASE_F32) b = *(const f32x4*)(base_s + (size_t)rr * DM + col);
        else { const u32x2 w = *(const u32x2*)(XB + (size_t)r * DM + col); b = (f32x4){bflo(w.x), bfhi(w.x), bflo(w.y), bfhi(w.y)}; }
        const f32x4 v = b + acc[0] * scale;
        if (OUT_F32) *(f32x4*)(X + (size_t)r * DM + col) = v;
        else { u32x2 w; w.x = pk2(v[0], v[1]); w.y = pk2(v[2], v[3]); *(u32x2*)(XB + (size_t)r * DM + col) = w; }
        sq = (v[0] * v[0] + v[1] * v[1]) + (v[2] * v[2] + v[3] * v[3]);
    }
    sq += __shfl_xor(sq, 16);
    if (fq == 0) ssq[(size_t)rr * 128 + cg] = sq;
}
__device__ __forceinline__ void s_cq(LAS unsigned char* lds, const bf16_t* XBs, const bf16_t* Wt, bf16_t* QX, const float* ssq, float scale, int s, int wave, int lane) {
    const int fr = lane & 15, fq = lane >> 4;
    const int rg = s & 1, cg = s >> 1;
    int brow[1]; brow[0] = 8 * cg + (fr < 7 ? fr : 7);
    f32x4 acc[1]; sgemm1<1>(lds, XBs, Wt, DM, brow, 128 * rg, wave, lane, acc);
    const int rr = 128 * rg + 16 * wave + fr, r = NP + rr;
    const float rs = rstd_of(samp_ss(ssq, rr, fq)) * scale;
    if (fq < 2) { const f32x4 v = acc[0] * rs; u32x2 w; w.x = pk2(v[0], v[1]); w.y = pk2(v[2], v[3]); *(u32x2*)(QX + (size_t)r * DM + 8 * cg + 4 * fq) = w; }
}
__device__ __forceinline__ void s_win(LAS unsigned char* lds, const bf16_t* XBs, const bf16_t* Win, bf16_t* QB, bf16_t* KB, bf16_t* VB, bf16_t* UB, float* out, const float* ssq, int s, int wave, int lane) {
    const int fr = lane & 15, fq = lane >> 4;
    int brow[3]; brow[0] = 6 * s + (fr < 5 ? fr : 5);
    { const int c = 2 * s + (fr < 1 ? fr : 1); brow[1] = 1536 + (c >> 7) * 256 + (c & 127); brow[2] = brow[1] + 128; }
    f32x4 acc[2][3]; sgemm<3, 8>(lds, XBs, Win, DM, brow, wave, lane, acc);
#pragma unroll
    for (int mt = 0; mt < 2; ++mt) { const int r = NP + 32 * wave + 16 * mt + fr; const int rr = r - NP; const float rs = rstd_of(samp_ss(ssq, rr, fq));
#pragma unroll
        for (int e = 0; e < 4; ++e) if (4 * fq + e < 6) { const int col = 6 * s + 4 * fq + e, sec = col >> 9, cc = col & 511; const float v = acc[mt][0][e] * rs;
            if (sec == 0) QB[(size_t)r * 512 + cc] = (bf16_t)(pk2(v * (0.125f * LOG2E), 0.f) & 0xffffu);
            else if (sec == 1) { out[O_WKS + (size_t)rr * 512 + cc] = v; KB[(size_t)r * 512 + cc] = (bf16_t)(pk2(v, 0.f) & 0xffffu); }
            else { out[O_WVS + (size_t)rr * 512 + cc] = v; VB[(size_t)r * 512 + cc] = (bf16_t)(pk2(v, 0.f) & 0xffffu); } }
        if (fq == 0) {
#pragma unroll
            for (int e = 0; e < 2; ++e) { const int c = 2 * s + e; const float uu = acc[mt][1][e] * rs * sigm_f(acc[mt][2][e] * rs);
                UB[(size_t)r * 512 + c] = (bf16_t)(pk2(uu, 0.f) & 0xffffu); out[O_CS + ((size_t)(rr >> 3) * 30 + 22 + (rr & 7)) * 512 + c] = uu; } }
    }
}

#define XB_TMO      128
#define XB_XCNT(j)  (256  + 64 * (j))
#define XB_XSUB(j)  (1280 + 64 * (j))
#define XB_XGEN(j)  (2304 + 64 * (j))
#define XB_TOP      3328
#define XB_TOPGEN   3392
#define XCD_BAR_WORDS 3456
#define XB_SPIN_CAP (1u << 18)

__device__ __forceinline__ unsigned xb_ld(unsigned* p)              { return __hip_atomic_load(p, __ATOMIC_RELAXED, __HIP_MEMORY_SCOPE_AGENT); }
__device__ __forceinline__ unsigned xb_add(unsigned* p, unsigned v) { return __hip_atomic_fetch_add(p, v, __ATOMIC_RELAXED, __HIP_MEMORY_SCOPE_AGENT); }
__device__ __forceinline__ unsigned xb_xcc_id() { return (unsigned)__builtin_amdgcn_s_getreg((3 << 11) | 20) & 0xFu; }
#define XB_SPIN(cond, bar) do { unsigned _sp = 0; while (cond) { __builtin_amdgcn_s_sleep(1); \
    if ((++_sp & 255u) == 0u) { if (xb_ld(&(bar)[XB_TMO])) break; if (_sp > XB_SPIN_CAP) { atomicAdd(&(bar)[XB_TMO], 1u); break; } } } } while (0)

struct XcdBarrier {
    unsigned* bar; unsigned x;
    volatile LAS unsigned* st;
};

__device__ __forceinline__ XcdBarrier xcd_barrier_post(unsigned* bar, volatile LAS unsigned* st) {
    XcdBarrier b; b.bar = bar; b.x = xb_xcc_id(); b.st = st;
    if (threadIdx.x == 0) (void)xb_add(&bar[XB_XCNT(b.x)], 1u);
    return b;
}
__device__ __forceinline__ void xcd_barrier_complete(unsigned* bar, unsigned x, unsigned& nloc, unsigned& nx) {
    const unsigned G = gridDim.x * gridDim.y * gridDim.z;
    unsigned sum, cnt, mine, sp = 0u;
    for (;;) {
        sum = 0u; cnt = 0u; mine = 0u;
#pragma unroll
        for (unsigned j = 0; j < 16; ++j) { const unsigned c = xb_ld(&bar[XB_XCNT(j)]); sum += c; cnt += (c > 0u) ? 1u : 0u; mine = (j == x) ? c : mine; }
        if (sum == G) break;
        __builtin_amdgcn_s_sleep(1);
        if ((++sp & 255u) == 0u) { if (xb_ld(&bar[XB_TMO])) break; if (sp > XB_SPIN_CAP) { atomicAdd(&bar[XB_TMO], 1u); break; } }
    }
    nloc = mine > 0u ? mine : 1u; nx = cnt > 0u ? cnt : 1u;
}

__device__ __forceinline__ void xcd_barrier(const XcdBarrier& b) {
    asm volatile("s_waitcnt vmcnt(0)" ::: "memory");
    __syncthreads();
    if (threadIdx.x == 0) {
        unsigned* bar = b.bar;
        __builtin_amdgcn_s_waitcnt(0);
        unsigned nloc = b.st[0], nx = b.st[1];
        if (nloc == 0u) { xcd_barrier_complete(bar, b.x, nloc, nx); b.st[0] = nloc; b.st[1] = nx; }
        const unsigned old = xb_add(&bar[XB_XSUB(b.x)], 1u);
        const unsigned gen = old / nloc;
        if (old + 1u == (gen + 1u) * nloc) {
            __builtin_amdgcn_fence(__ATOMIC_RELEASE, "agent");
            asm volatile("s_waitcnt vmcnt(0)" ::: "memory");
            const unsigned og = xb_add(&bar[XB_TOP], 1u);
            const unsigned tg = og / nx;
            if (og + 1u == (tg + 1u) * nx) xb_add(&bar[XB_TOPGEN], 1u);
            else XB_SPIN(xb_ld(&bar[XB_TOPGEN]) == tg, bar);
            __builtin_amdgcn_fence(__ATOMIC_ACQUIRE, "agent");
            xb_add(&bar[XB_XGEN(b.x)], 1u);
            asm volatile("s_waitcnt vmcnt(0)" ::: "memory");
        } else {
            XB_SPIN(xb_ld(&bar[XB_XGEN(b.x)]) == gen, bar);
            __builtin_amdgcn_fence(__ATOMIC_ACQUIRE, "agent");
            asm volatile("s_waitcnt vmcnt(0)" ::: "memory");
        }
    }
    __syncthreads();
}

#define GEMM_PHASE(EPI, A_, B_, M_, N_, K_, E_) do { pg8::Gemm g_{(const bf16_t*)(A_), (const bf16_t*)(B_), (M_), (N_), (K_)}; pg8::StaticOrder S_; S_.init((M_), (N_), G, (int)blockIdx.x); \
        pg8::gemm_phase<EPI, pg8::StaticOrder, true, true>(lds, g_, S_, (E_)); } while (0)

#ifndef REP_P0
#define REP_P0 1
#endif
#define STAGGER2(GEMM_STMT, SLICE_STMT) do { if (bx & 1) { for (int sl = bx; sl < 256; sl += G) { SLICE_STMT; } __syncthreads();   } GEMM_STMT; if (!(bx & 1)) { for (int sl = bx; sl < 256; sl += G) { SLICE_STMT; } } } while (0)
__global__ void __launch_bounds__(NTHREADS, 2) fwd_megakernel(Args args) {
    extern __shared__ __attribute__((aligned(16))) unsigned char lds_raw[];
    LAS unsigned char* lds = (LAS unsigned char*)lds_raw;
    const int tid = threadIdx.x, lane = tid & 63, wave = __builtin_amdgcn_readfirstlane(tid >> 6);
    const int G = gridDim.x, bx = blockIdx.x;
    unsigned char* ws = args.ws; float* out = args.out;
    float* ssq0 = (float*)(ws + WS_SSQ0); float* ssqm = (float*)(ws + WS_SSQM); float* ssqp = (float*)(ws + WS_SSQP); float* ssqs = (float*)(ws + WS_SSQS);
#define SSQP(k) (ssqp + (size_t)(k) * NP * 16)
#define SSQS(k) (ssqs + (size_t)(k) * 256 * 128)

    bf16_t* XB = (bf16_t*)(ws + WS_XB); bf16_t* MEMB = (bf16_t*)(ws + WS_MEMB); bf16_t* MKB = (bf16_t*)(ws + WS_MKB); bf16_t* MVB = (bf16_t*)(ws + WS_MVB);
    bf16_t* QB = (bf16_t*)(ws + WS_QB); bf16_t* KB = (bf16_t*)(ws + WS_KB); bf16_t* VB = (bf16_t*)(ws + WS_VB); bf16_t* UB = (bf16_t*)(ws + WS_UB);
    bf16_t* MIX = (bf16_t*)(ws + WS_MIX); bf16_t* QX = (bf16_t*)(ws + WS_QX); bf16_t* OX = (bf16_t*)(ws + WS_OX); bf16_t* ACT = (bf16_t*)(ws + WS_ACT);
    bf16_t* Wgu1 = (bf16_t*)(ws + WS_WGU1); bf16_t* Wd1 = (bf16_t*)(ws + WS_WD1); bf16_t* Win = (bf16_t*)(ws + WS_WIN); bf16_t* Wout = (bf16_t*)(ws + WS_WOUT);
    bf16_t* Wcq = (bf16_t*)(ws + WS_WCQ); bf16_t* Wckv = (bf16_t*)(ws + WS_WCKV); bf16_t* Wco = (bf16_t*)(ws + WS_WCO); bf16_t* Wgu2 = (bf16_t*)(ws + WS_WGU2); bf16_t* Wd2 = (bf16_t*)(ws + WS_WD2);
    const float* x_prompt = args.in[0]; const float* x_sample = args.in[1];
    float* X = out + O_Y;
    const int lo = args.ph_lo, hi = args.ph_hi;
    if (tid < 4) ((volatile LAS unsigned*)(lds + LDS_BYTES - 16))[tid] = 0u;
    __syncthreads();
    XcdBarrier xbar = xcd_barrier_post((unsigned*)(ws + WS_BAR), (volatile LAS unsigned*)(lds + LDS_BYTES - 16));
#ifndef SKIPMASK
#define SKIPMASK 0
#endif
#define IN(k) (!((SKIPMASK >> (k)) & 1) && lo <= (k) && (k) < hi)
#define SEAM(k) do { if (IN(k) && IN((k) + 1)) xcd_barrier(xbar); } while (0)

    if (IN(0)) {
        LAS float* scr = (LAS float*)(lds + wave * 16384);
        const int gw = bx * NWAVES + wave, NGW = G * NWAVES;
        constexpr int I_G = 16 * 88, I_D = 44 * 32, I_IN = 16 * 80, I_SQ = 16 * 32;
        constexpr int NITEMS = 6 * I_G + I_IN + 5 * I_SQ;
        for (int it = gw; it < NITEMS; it += NGW) {
            int r = it;
            if (r < I_G) { p0_transpose_item(args.in[9], DM, FF, Wgu1, 1, 0, args.in[8], scr, r, lane); continue; } r -= I_G;
            if (r < I_G) { p0_transpose_item(args.in[10], DM, FF, Wgu1, 2, 0, args.in[8], scr, r, lane); continue; } r -= I_G;
            if (r < I_D) { p0_transpose_item(args.in[11], FF, DM, Wd1, 0, 0, nullptr, scr, r, lane); continue; } r -= I_D;
            if (r < I_G) { p0_transpose_item(args.in[26], DM, FF, Wgu2, 1, 0, args.in[25], scr, r, lane); continue; } r -= I_G;
            if (r < I_G) { p0_transpose_item(args.in[27], DM, FF, Wgu2, 2, 0, args.in[25], scr, r, lane); continue; } r -= I_G;
            if (r < I_D) { p0_transpose_item(args.in[28], FF, DM, Wd2, 0, 0, nullptr, scr, r, lane); continue; } r -= I_D;
            if (r < I_IN) { p0_transpose_item(args.in[13], DM, 2560, Win, 3, 0, args.in[12], scr, r, lane); continue; } r -= I_IN;
            if (r < I_SQ) { p0_transpose_item(args.in[18], DM, DM, Wout, 0, 0, nullptr, scr, r, lane); continue; } r -= I_SQ;
            if (r < I_SQ) { p0_transpose_item(args.in[21], DM, DM, Wcq, 0, 0, args.in[19], scr, r, lane); continue; } r -= I_SQ;
            if (r < I_SQ) { p0_transpose_item(args.in[22], DM, DM, Wckv, 0, 0, args.in[20], scr, r, lane); continue; } r -= I_SQ;
            if (r < I_SQ) { p0_transpose_item(args.in[23], DM, DM, Wckv, 0, 1024, args.in[20], scr, r, lane); continue; } r -= I_SQ;
            p0_transpose_item(args.in[24], DM, DM, Wco, 0, 0, nullptr, scr, r, lane);
        }
        for (int m = gw; m < MT; m += 2 * NGW) {
            const int m1 = (m + NGW < MT) ? m + NGW : m;
            row2_to_bf16(m < NP ? x_prompt + (size_t)m * DM : x_sample + (size_t)(m - NP) * DM, m1 < NP ? x_prompt + (size_t)m1 * DM : x_sample + (size_t)(m1 - NP) * DM,
                         XB + (size_t)m * DM, XB + (size_t)m1 * DM, ssq0 + m, ssq0 + m1, lane);
        }
        for (int m = gw; m < NMEMROWS; m += NGW) row_to_bf16(args.in[2] + (size_t)m * DM, MEMB + (size_t)m * DM, ssqm + m, lane);
        for (int i = bx * NTHREADS + tid; i < 32 * 22 * 128; i += G * NTHREADS) { const int b = i / (22 * 128), rem = i - b * (22 * 128);
            *(f32x4*)(out + O_CS + (size_t)b * 30 * 512 + rem * 4) = *(const f32x4*)(args.in[5] + (size_t)b * 30 * 512 + 8 * 512 + rem * 4); }
    }
    SEAM(0);
    if (IN(1)) {
        { EpiGU<false> E{ACT, ssq0}; STAGGER2(GEMM_PHASE(EpiGU<false>, XB, Wgu1, NP, 2 * FF, DM, E), s_gu<false>(lds, XB + (size_t)NP * DM, Wgu1, ACT, ssq0, sl, wave, lane)); }
        __syncthreads();
        { EpiMemKV E{MKB, MVB, out, ssqm}; GEMM_PHASE(EpiMemKV, MEMB, Wckv, NMEMROWS, 2048, DM, E); }
    }
    SEAM(1);
    if (IN(2)) { typedef EpiRes<true, false> ER; ER E{x_prompt, X, XB, SSQP(0), 0.5f};
        STAGGER2(GEMM_PHASE(ER, ACT, Wd1, NP, DM, FF, E), (s_res<true, false>(lds, ACT + (size_t)NP * FF, FF, Wd1, x_sample, X, XB, SSQS(0), 0.5f, sl, wave, lane))); }
    SEAM(2);
    if (IN(3)) { EpiWin E{QB, KB, VB, UB, out, SSQP(0)}; STAGGER2(GEMM_PHASE(EpiWin, XB, Win, NP, 2560, DM, E), s_win(lds, XB + (size_t)NP * DM, Win, QB, KB, VB, UB, out, SSQS(0), sl, wave, lane)); }
    SEAM(3);
    if (IN(4)) {
#ifndef REP_AP
#define REP_AP 1
#endif
#ifndef REP_AS
#define REP_AS 1
#endif
#ifndef REP_CV
#define REP_CV 1
#endif
#ifndef REP_XA
#define REP_XA 1
#endif
#ifndef REP_P0
#define REP_P0 1
#endif
#ifndef NO_ATTNP
        for (int rep = 0; rep < REP_AP; ++rep)
        for (int u = bx; u < 1024; u += G) {
            const int xcd = u & 7, j = u >> 3; const int b = xcd * 2 + (j >> 6), jj = j & 63, h = jj & 7, blk = jj >> 3;
            attn_prompt_unit(lds, QB, KB, VB, MIX, b, h, blk, wave, lane);
        }
#endif
#ifndef NO_ATTNS
        for (int rep = 0; rep < REP_AS; ++rep)
        for (int u = bx; u < 256; u += G) attn_sample_unit(lds, QB, args.in[3], args.in[4], out, MIX, u >> 3, u & 7, wave, lane);
#endif
        __syncthreads();
#ifndef NO_CONV
        for (int rep = 0; rep < REP_CV; ++rep)
        for (int u = bx; u < 512 + 32; u += G) {
            if (u < 512) conv_unit(lds, 0, u >> 5, (u & 31) * 64, UB, args.in[5], args.in[14], args.in[15], args.in[16], args.in[17], MIX, tid, wave, lane);
            else conv_unit(lds, 1, u - 512, 0, UB, args.in[5], args.in[14], args.in[15], args.in[16], args.in[17], MIX, tid, wave, lane);
        }
#endif
    }
    SEAM(4);
    if (IN(5)) { typedef EpiRes<false, false> ER; ER E{nullptr, X, XB, SSQP(1), 1.0f};
        STAGGER2(GEMM_PHASE(ER, MIX, Wout, NP, DM, DM, E), (s_res<false, false>(lds, MIX + (size_t)NP * DM, DM, Wout, nullptr, X, XB, SSQS(1), 1.0f, sl, wave, lane))); }
    SEAM(5);
    if (IN(6)) { EpiCQ E{QX, SSQP(1), 0.0625f * LOG2E}; STAGGER2(GEMM_PHASE(EpiCQ, XB, Wcq, NP, DM, DM, E), s_cq(lds, XB + (size_t)NP * DM, Wcq, QX, SSQS(1), 0.0625f * LOG2E, sl, wave, lane)); }
    SEAM(6);
    if (IN(7)) {
        for (int rep = 0; rep < REP_XA; ++rep)
        for (int u = bx; u < 1024 + 128; u += G) {
            if (u < 1024) { const int h = u & 3, qb = u >> 2; const int b = qb >> 4;
                xattn_unit(lds, MKB + (size_t)b * 256 * DM + h * 256, MVB + (size_t)b * 256 * DM + h * 256, false, DM, QX, OX, qb * 128, 128, h, tid, wave, lane); }
            else { const int v = u - 1024, b = v >> 2, h = v & 3;
                xattn_unit(lds, args.in[6] + ((size_t)b * 256 * 4 + h) * 256, args.in[7] + ((size_t)b * 256 * 4 + h) * 256, true, DM, QX, OX, NP + b * 8, 8, h, tid, wave, lane); }
        }
    }
    SEAM(7);
    if (IN(8)) { typedef EpiRes<false, false> ER; ER E{nullptr, X, XB, SSQP(2), 1.0f};
        STAGGER2(GEMM_PHASE(ER, OX, Wco, NP, DM, DM, E), (s_res<false, false>(lds, OX + (size_t)NP * DM, DM, Wco, nullptr, X, XB, SSQS(2), 1.0f, sl, wave, lane))); }
    SEAM(8);
    if (IN(9)) { EpiGU<true> E{ACT, SSQP(2)}; STAGGER2(GEMM_PHASE(EpiGU<true>, XB, Wgu2, NP, 2 * FF, DM, E), s_gu<true>(lds, XB + (size_t)NP * DM, Wgu2, ACT, SSQS(2), sl, wave, lane)); }
    SEAM(9);
    if (IN(10)) { typedef EpiRes<false, false> ER; ER E{nullptr, X, XB, SSQP(3), 0.5f};
        STAGGER2(GEMM_PHASE(ER, ACT, Wd2, NP, DM, FF, E), (s_res<false, false>(lds, ACT + (size_t)NP * FF, FF, Wd2, nullptr, X, XB, SSQS(3), 0.5f, sl, wave, lane))); }
    SEAM(10);
    if (IN(11)) {
        const int gw = bx * NWAVES + wave, NGW = G * NWAVES;
        const float* gf = args.in[29];
        f32x4 gg[4];
#pragma unroll
        for (int j = 0; j < 4; ++j) gg[j] = ((const f32x4*)gf)[lane + 64 * j];
        for (int m = gw; m < MT; m += 2 * NGW) {
            const int m1 = (m + NGW < MT) ? m + NGW : m;
            float ss0, ss1;
            if (m < NP) ss0 = rowss<true>(SSQP(3), m); else { const f32x2 t = ((const f32x2*)(SSQS(3) + (size_t)(m - NP) * 128))[lane]; ss0 = wave_sum(t[0] + t[1]); }
            if (m1 < NP) ss1 = rowss<true>(SSQP(3), m1); else { const f32x2 t = ((const f32x2*)(SSQS(3) + (size_t)(m1 - NP) * 128))[lane]; ss1 = wave_sum(t[0] + t[1]); }
            const float rs0 = rstd_of(ss0), rs1 = rstd_of(ss1);
            f32x4* xr0 = (f32x4*)(X + (size_t)m * DM) + lane; f32x4* xr1 = (f32x4*)(X + (size_t)m1 * DM) + lane;
            const u32x2* br0 = (const u32x2*)(XB + (size_t)m * DM) + lane; const u32x2* br1 = (const u32x2*)(XB + (size_t)m1 * DM) + lane;
            u32x2 w0[4], w1[4];
#pragma unroll
            for (int j = 0; j < 4; ++j) { w0[j] = __builtin_nontemporal_load(br0 + 64 * j); w1[j] = __builtin_nontemporal_load(br1 + 64 * j); }
#pragma unroll
            for (int j = 0; j < 4; ++j) {
                const f32x4 v0 = (f32x4){bflo(w0[j].x), bfhi(w0[j].x), bflo(w0[j].y), bfhi(w0[j].y)}, v1 = (f32x4){bflo(w1[j].x), bfhi(w1[j].x), bflo(w1[j].y), bfhi(w1[j].y)};
                __builtin_nontemporal_store(v0 * rs0 * gg[j], xr0 + 64 * j); if (m1 != m) __builtin_nontemporal_store(v1 * rs1 * gg[j], xr1 + 64 * j); }
        }
    }
#undef IN
#undef SEAM
}

#ifndef MK_N_LAUNCHES
#define MK_N_LAUNCHES 1
#endif
extern "C" void kernel_launch(void* const* d_in, const int* in_sizes, int n_in, void* d_out, int out_size, void* d_ws, size_t ws_size, hipStream_t stream) {
    static int grid = 0;
    if (grid == 0) {
        if (n_in != 30 || (size_t)out_size != O_END || ws_size < WS_END) { fprintf(stderr, "kernel_launch: unexpected sizes: n_in %d out %d ws %zu\n", n_in, out_size, ws_size); grid = -1; return; }
        int dev = 0, cus = 0, per_cu = 0;
        hipGetDevice(&dev); hipDeviceGetAttribute(&cus, hipDeviceAttributeMultiprocessorCount, dev);
        if (hipFuncSetAttribute((const void*)fwd_megakernel, hipFuncAttributeMaxDynamicSharedMemorySize, LDS_BYTES) != hipSuccess) { fprintf(stderr, "kernel_launch: hipFuncSetAttribute failed\n"); grid = -1; return; }
        if (hipOccupancyMaxActiveBlocksPerMultiprocessor(&per_cu, (const void*)fwd_megakernel, NTHREADS, LDS_BYTES) != hipSuccess || per_cu < 1) { fprintf(stderr, "kernel_launch: occupancy query says %d blocks per CU\n", per_cu); grid = -1; (void)hipGetLastError(); return; }
        grid = cus;
        if (grid > 256) grid = 256;
    }
    if (grid < 0) return;
    Args a{};
    for (int i = 0; i < 30; ++i) a.in[i] = (const float*)d_in[i];
    a.out = (float*)d_out; a.ws = (unsigned char*)d_ws;
#if MK_N_LAUNCHES == 1
    a.ph_lo = 0; a.ph_hi = 12;
    if (hipMemsetAsync((char*)d_ws + WS_BAR, 0, XCD_BAR_WORDS * sizeof(unsigned), stream) != hipSuccess) { fprintf(stderr, "kernel_launch: hipMemsetAsync of the barrier words failed; nothing launched\n"); return; }
    hipLaunchKernelGGL(fwd_megakernel, dim3(grid), dim3(NTHREADS), LDS_BYTES, stream, a);
    const hipError_t e = hipPeekAtLastError();
    if (e != hipSuccess) fprintf(stderr, "kernel_launch: launch failed: %s (grid %d)\n", hipGetErrorString(e), grid);
#else
    for (int p = 0; p < 12; ++p) { a.ph_lo = p; a.ph_hi = p + 1; hipLaunchKernelGGL(fwd_megakernel, dim3(grid), dim3(NTHREADS), LDS_BYTES, stream, a); }
#endif
}
```
